# Optimizing an MI355X kernel written in HIP

```python
import math
import jax, jax.numpy as jnp
from jax import lax
import numpy as np

D_MODEL = 1024
BATCH = 4
SEQ = 8192
DEPTH = 1

MEM_LEN = 256
M_HEADS = 4
M_DQK = 128
M_DV = 256
CHUNK = 128
CONV_K = 4
D_HEADS = 8
D_HD = 64
D_DV = 2 * D_HD
Q_BLOCK = 128
C_HEADS = 4
C_DQK = 128
C_DV = 256
D_FF = 4 * D_MODEL
N_BRANCH = 3
EPS = 1e-6

M_QK_W = M_HEADS * M_DQK
M_V_W = M_HEADS * M_DV
D_Q_W = D_HEADS * 2 * D_HD
D_V_W = D_HEADS * D_DV
C_Q_W = C_HEADS * C_DQK
C_V_W = C_HEADS * C_DV
IN_SPLIT_SIZES = (M_QK_W, M_QK_W, M_V_W, M_HEADS, M_HEADS, M_V_W, D_Q_W, D_Q_W, D_V_W, C_Q_W)
IN_COLS = sum(IN_SPLIT_SIZES)

kernel_name = 'hybrid_mlstm_diffattn_memxattn_block'


def rms_norm(x, g):
    xf = x.astype(jnp.float32)
    y = xf * lax.rsqrt(jnp.mean(xf * xf, axis=-1, keepdims=True) + EPS)
    return (y * g.astype(jnp.float32)).astype(x.dtype)


def lambda_init(layer):
    return 0.8 - 0.6 * math.exp(-0.3 * layer)


def causal_depthwise_conv(x, w, b):
    c = x.shape[-1]
    y = lax.conv_general_dilated(x, w.astype(x.dtype).reshape(CONV_K, 1, c), window_strides=(1,),
                                 padding=[(CONV_K - 1, 0)], dimension_numbers=('NWC', 'WIO', 'NWC'),
                                 feature_group_count=c)
    return y + b.astype(x.dtype)


def mlstm_chunkwise(q, k, v, ig, fg_pre):
    bsz, seq, nh, dk = q.shape
    dv = v.shape[-1]
    nc = seq // CHUNK
    f32 = jnp.float32

    def to_chunks(t):
        t = t.astype(f32).reshape(bsz, nc, CHUNK, nh, -1)
        return t.transpose(1, 0, 3, 2, 4)

    qc = to_chunks(q * (dk ** -0.5))
    kc = to_chunks(k)
    vc = to_chunks(v)
    igc = to_chunks(ig[..., None])[..., 0]
    lfc = to_chunks(jax.nn.log_sigmoid(fg_pre.astype(f32))[..., None])[..., 0]
    causal = jnp.tril(jnp.ones((CHUNK, CHUNK), dtype=bool))

    def step(carry, xs):
        C, n, m = carry
        qq, kk, vv, ii, lf = xs
        bcum = jnp.cumsum(lf, axis=-1)
        logd = bcum[..., :, None] - bcum[..., None, :] + ii[..., None, :]
        logd = jnp.where(causal, logd, -jnp.inf)
        inter = bcum + m[..., None]
        m_loc = jnp.maximum(inter, jnp.max(logd, axis=-1))
        w_intra = jnp.exp(logd - m_loc[..., None])
        w_inter = jnp.exp(inter - m_loc)
        s = jnp.einsum('bhjd,bhsd->bhjs', qq, kk) * w_intra
        num = jnp.einsum('bhjs,bhsv->bhjv', s, vv) + w_inter[..., None] * jnp.einsum('bhjd,bhdv->bhjv', qq, C)
        den = jnp.sum(s, axis=-1) + w_inter * jnp.einsum('bhjd,bhd->bhj', qq, n)
        h = num / jnp.maximum(jnp.abs(den), jnp.exp(-m_loc))[..., None]
        b_end = bcum[..., -1]
        log_w = b_end[..., None] - bcum + ii
        m_new = jnp.maximum(b_end + m, jnp.max(log_w, axis=-1))
        w_s = jnp.exp(log_w - m_new[..., None])
        decay = jnp.exp(b_end + m - m_new)
        C_new = decay[..., None, None] * C + jnp.einsum('bhs,bhsd,bhsv->bhdv', w_s, kk, vv)
        n_new = decay[..., None] * n + jnp.einsum('bhs,bhsd->bhd', w_s, kk)
        return (C_new, n_new, m_new), h

    init = (jnp.zeros((bsz, nh, dk, dv), f32), jnp.zeros((bsz, nh, dk), f32), jnp.zeros((bsz, nh), f32))
    _, hc = lax.scan(step, init, (qc, kc, vc, igc, lfc))
    return hc.transpose(1, 0, 3, 2, 4).reshape(bsz, seq, nh, dv)


def diff_attention(q, k, v, q_g, k_g, lam, subln_g, lam_init):
    q = rms_norm(q, q_g)
    k = rms_norm(k, k_g)
    bsz, seq, nh, _, d = q.shape
    nb = seq // Q_BLOCK
    qb = q.reshape(bsz, nb, Q_BLOCK, nh, 2, d).transpose(1, 0, 3, 4, 2, 5)
    kt = k.transpose(0, 2, 3, 1, 4)
    vt = v.transpose(0, 2, 1, 3)
    kpos = jnp.arange(seq)
    scale = d ** -0.5

    def block(args):
        qblk, i = args
        s = jnp.einsum('bhcqd,bhckd->bhcqk', qblk, kt).astype(jnp.float32) * scale
        qpos = i * Q_BLOCK + jnp.arange(Q_BLOCK)
        s = jnp.where(kpos[None, :] <= qpos[:, None], s, -jnp.inf)
        p = jax.nn.softmax(s, axis=-1)
        a = p[:, :, 0] - lam * p[:, :, 1]
        return jnp.einsum('bhqk,bhkv->bhqv', a.astype(vt.dtype), vt)

    o = lax.map(block, (qb, jnp.arange(nb)))
    o = o.transpose(1, 0, 3, 2, 4).reshape(bsz, seq, nh, -1)
    o = rms_norm(o, subln_g) * (1.0 - lam_init)
    return o.reshape(bsz, seq, -1)


def memory_cross_attention(q, mem, mem_g, w_kv, q_g, k_g):
    bsz, seq, _ = q.shape
    qh = rms_norm(q.reshape(bsz, seq, C_HEADS, C_DQK), q_g)
    mkv = rms_norm(mem, mem_g) @ w_kv
    mk, mv = jnp.split(mkv, [C_Q_W], axis=-1)
    mk = rms_norm(mk.reshape(bsz, -1, C_HEADS, C_DQK), k_g)
    mv = mv.reshape(bsz, -1, C_HEADS, C_DV)
    s = jnp.einsum('bshd,bmhd->bhsm', qh, mk).astype(jnp.float32) * (C_DQK ** -0.5)
    p = jax.nn.softmax(s, axis=-1)
    o = jnp.einsum('bhsm,bmhv->bshv', p.astype(mv.dtype), mv)
    return o.reshape(bsz, seq, -1)


def setup_inputs(seed: int = 0) -> dict:
    key = jax.random.key(seed)
    ks = iter(jax.random.split(key, 40))

    def nrm(shape, scale):
        return scale * jax.random.normal(next(ks), shape, jnp.float32)

    def gain(shape):
        return 1.0 + nrm(shape, 0.02)

    L = DEPTH
    return {
        'x': nrm((BATCH, SEQ, D_MODEL), 1.0),
        'mem': nrm((BATCH, MEM_LEN, D_MODEL), 1.0),
        'norm_mix_g': gain((L, D_MODEL)),
        'w_in': nrm((L, D_MODEL, IN_COLS), D_MODEL ** -0.5),
        'b_igate': nrm((L, M_HEADS), 0.1),
        'b_fgate': jnp.linspace(3.0, 6.0, M_HEADS, dtype=jnp.float32)[None, :] + nrm((L, M_HEADS), 0.1),
        'conv_w': nrm((L, CONV_K, 2 * M_QK_W), CONV_K ** -0.5),
        'conv_b': nrm((L, 2 * M_QK_W), 0.02),
        'm_norm_g': gain((L, M_V_W)),
        'dq_norm_g': gain((L, D_HD)),
        'dk_norm_g': gain((L, D_HD)),
        'lam_q1': nrm((L, D_HD), 0.1),
        'lam_k1': nrm((L, D_HD), 0.1),
        'lam_q2': nrm((L, D_HD), 0.1),
        'lam_k2': nrm((L, D_HD), 0.1),
        'subln_g': gain((L, D_DV)),
        'cq_norm_g': gain((L, C_DQK)),
        'ck_norm_g': gain((L, C_DQK)),
        'mem_norm_g': gain((L, D_MODEL)),
        'w_mem_kv': nrm((L, D_MODEL, C_Q_W + C_V_W), D_MODEL ** -0.5),
        'w_gate': nrm((L, D_MODEL, N_BRANCH * D_MODEL), D_MODEL ** -0.5),
        'b_gate': nrm((L, N_BRANCH * D_MODEL), 0.02),
        'w_proj_m': nrm((L, M_V_W, D_MODEL), M_V_W ** -0.5),
        'w_proj_d': nrm((L, D_V_W, D_MODEL), D_V_W ** -0.5),
        'w_proj_c': nrm((L, C_V_W, D_MODEL), C_V_W ** -0.5),
        'w_out': nrm((L, D_MODEL, D_MODEL), D_MODEL ** -0.5),
        'norm_mlp_g': gain((L, D_MODEL)),
        'w_up': nrm((L, D_MODEL, D_FF), D_MODEL ** -0.5),
        'w_down': nrm((L, D_FF, D_MODEL), D_FF ** -0.5),
    }


def reference(x, mem, norm_mix_g, w_in, b_igate, b_fgate, conv_w, conv_b, m_norm_g, dq_norm_g, dk_norm_g,
              lam_q1, lam_k1, lam_q2, lam_k2, subln_g, cq_norm_g, ck_norm_g, mem_norm_g, w_mem_kv,
              w_gate, b_gate, w_proj_m, w_proj_d, w_proj_c, w_out, norm_mlp_g, w_up, w_down):
    split_idx = np.cumsum(np.array(IN_SPLIT_SIZES))[:-1].tolist()
    bsz, seq, _ = x.shape
    for l in range(DEPTH):
        h = rms_norm(x, norm_mix_g[l])
        proj = h @ w_in[l]
        mq, mk, mv, mi, mf, mo, dq, dk, dv, cq = jnp.split(proj, split_idx, axis=-1)

        qk = jax.nn.silu(causal_depthwise_conv(jnp.concatenate([mq, mk], axis=-1), conv_w[l], conv_b[l]))
        mq, mk = jnp.split(qk, 2, axis=-1)
        hm = mlstm_chunkwise(mq.reshape(bsz, seq, M_HEADS, M_DQK), mk.reshape(bsz, seq, M_HEADS, M_DQK),
                             mv.reshape(bsz, seq, M_HEADS, M_DV), mi + b_igate[l], mf + b_fgate[l]).astype(x.dtype)
        y_m = jax.nn.sigmoid(mo) * rms_norm(hm, m_norm_g[l].reshape(M_HEADS, M_DV)).reshape(bsz, seq, M_V_W)

        lam_i = lambda_init(l)
        lam = (jnp.exp(jnp.sum(lam_q1[l].astype(jnp.float32) * lam_k1[l].astype(jnp.float32)))
               - jnp.exp(jnp.sum(lam_q2[l].astype(jnp.float32) * lam_k2[l].astype(jnp.float32))) + lam_i)
        y_d = diff_attention(dq.reshape(bsz, seq, D_HEADS, 2, D_HD), dk.reshape(bsz, seq, D_HEADS, 2, D_HD),
                             dv.reshape(bsz, seq, D_HEADS, D_DV), dq_norm_g[l], dk_norm_g[l], lam,
                             subln_g[l], lam_i)

        y_c = memory_cross_attention(cq, mem, mem_norm_g[l], w_mem_kv[l], cq_norm_g[l], ck_norm_g[l])

        g_m, g_d, g_c = jnp.split(jax.nn.sigmoid(h @ w_gate[l] + b_gate[l]), N_BRANCH, axis=-1)
        merged = g_m * (y_m @ w_proj_m[l]) + g_d * (y_d @ w_proj_d[l]) + g_c * (y_c @ w_proj_c[l])
        x = x + merged @ w_out[l]

        h2 = rms_norm(x, norm_mlp_g[l])
        x = x + jnp.square(jax.nn.relu(h2 @ w_up[l])) @ w_down[l]
    return x
```

```cpp
#include <hip/hip_runtime.h>
#include <hip/hip_cooperative_groups.h>
#include <cstdio>
#include <cstdint>
namespace cg = cooperative_groups;

#ifndef MULTI_LAUNCH
#define MULTI_LAUNCH 0
#endif

typedef unsigned short bf16_t;
typedef short bf16x8 __attribute__((ext_vector_type(8)));
typedef float f32x4 __attribute__((ext_vector_type(4)));
#define MFMA(a, b, c) __builtin_amdgcn_mfma_f32_16x16x32_bf16((a), (b), (c), 0, 0, 0)

constexpr int T_TOK = 32768, DM = 1024, SEQ = 8192, NB = 4;
constexpr int LDP = 6656;
constexpr int C_MQ = 0, C_MK = 512, C_MV = 1024, C_MO = 2048, C_DQ = 3072, C_DK = 4096, C_DV = 5120, C_CQ = 6144;
constexpr float EPS = 1e-6f;

constexpr size_t OFF_PROJ = 0;
constexpr size_t OFF_W1   = OFF_PROJ + (size_t)T_TOK * LDP * 2;
constexpr size_t OFF_WG   = OFF_W1 + (size_t)6656 * 1024 * 2;
constexpr size_t OFF_WPM  = OFF_WG + (size_t)3072 * 1024 * 2;
constexpr size_t OFF_WPD  = OFF_WPM + (size_t)1024 * 1024 * 2;
constexpr size_t OFF_WPC  = OFF_WPD + (size_t)1024 * 1024 * 2;
constexpr size_t OFF_WOUT = OFF_WPC + (size_t)1024 * 1024 * 2;
constexpr size_t OFF_WUP  = OFF_WOUT + (size_t)1024 * 1024 * 2;
constexpr size_t OFF_WDN  = OFF_WUP + (size_t)4096 * 1024 * 2;
constexpr size_t OFF_WMKV = OFF_WDN + (size_t)4096 * 1024 * 2;
constexpr size_t OFF_HMEM = OFF_WMKV + (size_t)1536 * 1024 * 2;
constexpr size_t OFF_MKN  = OFF_HMEM + (size_t)1024 * 1024 * 2;
constexpr size_t OFF_VTC  = OFF_MKN + (size_t)1024 * 512 * 2;
constexpr size_t OFF_IG   = OFF_VTC + (size_t)16 * 256 * 256 * 2;
constexpr size_t OFF_LF   = OFF_IG + (size_t)T_TOK * 4 * 4;
constexpr size_t OFF_BCUM = OFF_LF + (size_t)T_TOK * 4 * 4;
constexpr size_t OFF_MPREV = OFF_BCUM + (size_t)T_TOK * 4 * 4;
constexpr size_t OFF_MNEW = OFF_MPREV + 4096;
constexpr size_t OFF_NST  = OFF_MNEW + 4096;
constexpr size_t OFF_CTR  = OFF_NST + (size_t)1024 * 128 * 4;
constexpr size_t OFF_XBAR = OFF_CTR + 256;
constexpr size_t OFF_SSQ  = OFF_XBAR + 16384;
constexpr size_t WS_END   = OFF_SSQ + (size_t)T_TOK * 4;
constexpr size_t OUT_H = 0, OUT_TMP = (size_t)T_TOK * 1024 * 2;

struct Params {
    const float* in[29];
    float* out;
    unsigned char* ws;
    long long ph_lo_hi;
};

typedef __bf16 bf2_t __attribute__((ext_vector_type(2)));
typedef float f2_t __attribute__((ext_vector_type(2)));
__device__ __forceinline__ bf16_t f2bf(float f) { return __builtin_bit_cast(bf16_t, (__bf16)f); }
__device__ __forceinline__ float bf2f(bf16_t b) { return __uint_as_float(((unsigned)b) << 16); }
__device__ __forceinline__ unsigned pack2(float a, float b) { f2_t f = {a, b}; bf2_t v = __builtin_convertvector(f, bf2_t); return __builtin_bit_cast(unsigned, v); }
__device__ __forceinline__ void unpack8(const uint4& v, float* f) {
    f[0] = __uint_as_float(v.x << 16); f[1] = __uint_as_float(v.x & 0xffff0000u);
    f[2] = __uint_as_float(v.y << 16); f[3] = __uint_as_float(v.y & 0xffff0000u);
    f[4] = __uint_as_float(v.z << 16); f[5] = __uint_as_float(v.z & 0xffff0000u);
    f[6] = __uint_as_float(v.w << 16); f[7] = __uint_as_float(v.w & 0xffff0000u);
}
__device__ __forceinline__ uint4 pack8(const float* f) { uint4 v; v.x = pack2(f[0], f[1]); v.y = pack2(f[2], f[3]); v.z = pack2(f[4], f[5]); v.w = pack2(f[6], f[7]); return v; }
__device__ __forceinline__ float sigmoidf_(float x) { return 1.0f / (1.0f + __expf(-x)); }
__device__ __forceinline__ float wave_sum(float v) { for (int m = 32; m >= 1; m >>= 1) v += __shfl_xor(v, m); return v; }
__device__ __forceinline__ float wave_max(float v) { for (int m = 32; m >= 1; m >>= 1) v = fmaxf(v, __shfl_xor(v, m)); return v; }

__device__ __forceinline__ int opaque_tid() { int t = threadIdx.x; asm volatile("" : "+v"(t)); return t; }

__device__ __forceinline__ int perm16(int r) { return (r & 3) | ((r & 4) << 1) | ((r & 8) >> 1); }
__device__ __forceinline__ int nq_of(int q) { return ((q & 1) << 3) | ((q >> 1) << 2); }


#define XB_TMO      128
#define XB_XCNT(j)  (256  + 64 * (j))
#define XB_XSUB(j)  (1280 + 64 * (j))
#define XB_XGEN(j)  (2304 + 64 * (j))
#define XB_TOP      3328
#define XB_TOPGEN   3392
#define XCD_BAR_WORDS 3456
#define XB_SPIN_CAP (1u << 20)
#define LAS __attribute__((address_space(3)))
__device__ __forceinline__ unsigned xb_ld(unsigned* p)              { return __hip_atomic_load(p, __ATOMIC_RELAXED, __HIP_MEMORY_SCOPE_AGENT); }
__device__ __forceinline__ unsigned xb_add(unsigned* p, unsigned v) { return __hip_atomic_fetch_add(p, v, __ATOMIC_RELAXED, __HIP_MEMORY_SCOPE_AGENT); }
__device__ __forceinline__ unsigned xb_xcc_id() { return (unsigned)__builtin_amdgcn_s_getreg((3 << 11) | 20) & 0xFu; }
#define XB_SPIN(cond, bar) do { unsigned _sp = 0; while (cond) { __builtin_amdgcn_s_sleep(1); \
    if ((++_sp & 255u) == 0u) { if (xb_ld(&(bar)[XB_TMO])) break; if (_sp > XB_SPIN_CAP) { atomicAdd(&(bar)[XB_TMO], 1u); break; } } } } while (0)
__device__ __forceinline__ void xcd_barrier_complete(unsigned* bar, unsigned x, unsigned& nloc, unsigned& nx) {
    const unsigned G = gridDim.x * gridDim.y * gridDim.z;
    unsigned sum, cnt, mine, sp = 0u;
    for (;;) {
        sum = 0u; cnt = 0u; mine = 0u;
#pragma unroll
        for (unsigned j = 0; j < 16; ++j) { const unsigned c = xb_ld(&bar[XB_XCNT(j)]); sum += c; cnt += (c > 0u) ? 1u : 0u; mine = (j == x) ? c : mine; }
        if (sum == G) break;
        __builtin_amdgcn_s_sleep(1);
        if ((++sp & 255u) == 0u) { if (xb_ld(&bar[XB_TMO])) break; if (sp > XB_SPIN_CAP) { atomicAdd(&bar[XB_TMO], 1u); break; } }
    }
    nloc = mine > 0u ? mine : 1u; nx = cnt > 0u ? cnt : 1u;
}
__device__ __forceinline__ void xcd_barrier(unsigned* bar, volatile LAS unsigned* st) {
    asm volatile("s_waitcnt vmcnt(0)" ::: "memory");
    __syncthreads();
    if (threadIdx.x == 0) {
        const unsigned x = xb_xcc_id();
        __builtin_amdgcn_s_waitcnt(0);
        unsigned nloc = st[0], nx = st[1];
        if (nloc == 0u) { xcd_barrier_complete(bar, x, nloc, nx); st[0] = nloc; st[1] = nx; }
        const unsigned old = xb_add(&bar[XB_XSUB(x)], 1u);
        const unsigned gen = old / nloc;
        if (old + 1u == (gen + 1u) * nloc) {
            __builtin_amdgcn_fence(__ATOMIC_RELEASE, "agent");
            asm volatile("s_waitcnt vmcnt(0)" ::: "memory");
            const unsigned og = xb_add(&bar[XB_TOP], 1u);
            const unsigned tg = og / nx;
            if (og + 1u == (tg + 1u) * nx) xb_add(&bar[XB_TOPGEN], 1u);
            else XB_SPIN(xb_ld(&bar[XB_TOPGEN]) == tg, bar);
            __builtin_amdgcn_fence(__ATOMIC_ACQUIRE, "agent");
            xb_add(&bar[XB_XGEN(x)], 1u);
            asm volatile("s_waitcnt vmcnt(0)" ::: "memory");
        } else {
            XB_SPIN(xb_ld(&bar[XB_XGEN(x)]) == gen, bar);
            __builtin_amdgcn_fence(__ATOMIC_ACQUIRE, "agent");
            asm volatile("s_waitcnt vmcnt(0)" ::: "memory");
        }
    }
    __syncthreads();
}

__device__ __forceinline__ void map_tile(int tile, int NT, int& mt, int& nt) {
    const int xcd = tile & 7, j = tile >> 3, ml = j & 7, jj = j >> 3;
    nt = jj % NT; const int mg = jj / NT; mt = xcd * 32 + mg * 8 + ml;
}

typedef unsigned v4u __attribute__((ext_vector_type(4)));
template <int NB_>
__device__ __forceinline__ void g_load(v4u (&ra)[4], v4u (&rb)[NB_], const bf16_t* gA, int lda, const bf16_t* gB, int ldb, int kt) {
    const int k0 = kt << 6;
#pragma unroll
    for (int i = 0; i < 4; ++i) ra[i] = *(const v4u*)(gA + (size_t)(i * 32) * lda + k0);
#pragma unroll
    for (int i = 0; i < NB_; ++i) rb[i] = *(const v4u*)(gB + (size_t)(i * 32) * ldb + k0);
}
template <int NB_>
__device__ __forceinline__ void s_store(const v4u (&ra)[4], const v4u (&rb)[NB_], bf16_t* dA, bf16_t* dB) {
#pragma unroll
    for (int i = 0; i < 4; ++i) *(v4u*)(dA + i * 32 * 64) = ra[i];
#pragma unroll
    for (int i = 0; i < NB_; ++i) *(v4u*)(dB + i * 32 * 64) = rb[i];
}
template <int NIA>
__device__ __forceinline__ void mma_step(f32x4 (&acc)[NIA][4], const bf16_t* pa, const bf16_t* pb, int c0a, int c0b) {
#pragma unroll
    for (int ks = 0; ks < 2; ++ks) {
        const int coa = c0a ^ (ks * 32), cob = c0b ^ (ks * 32);
        bf16x8 af[NIA], bfr[4];
#pragma unroll
        for (int i = 0; i < NIA; ++i) af[i] = *(const bf16x8*)(pa + i * 16 * 64 + coa);
#pragma unroll
        for (int j = 0; j < 4; ++j) bfr[j] = *(const bf16x8*)(pb + j * 16 * 64 + cob);
#pragma unroll
        for (int i = 0; i < NIA; ++i)
#pragma unroll
            for (int j = 0; j < 4; ++j) acc[i][j] = MFMA(af[i], bfr[j], acc[i][j]);
    }
}
template <int BN, bool SWAP>
__device__ __forceinline__ void gemm_acc(f32x4 (&acc)[BN / 32][4], const bf16_t* __restrict__ A, int lda, const bf16_t* __restrict__ Bt, int ldb,
                                         int K, unsigned char* smem) {
    constexpr int NB_ = BN / 32;
    constexpr int SA = 128 * 64, SB = BN * 64;
    bf16_t* sA = (bf16_t*)smem;
    bf16_t* sB = sA + 2 * SA;
    const int tid = opaque_tid(), lane = tid & 63, w = tid >> 6, r16 = lane & 15, q = lane >> 4;
    const int wa = w & 1, wb = w >> 1;
    const int nk = K >> 6;
    const bf16_t* gA = A + (size_t)(tid >> 3) * lda + (tid & 7) * 8;
    const bf16_t* gB = Bt + (size_t)(tid >> 3) * ldb + (tid & 7) * 8;
    const int soff = (tid >> 3) * 64 + (((tid & 7) ^ ((tid >> 4) & 7)) << 3);
    const int ra_ = SWAP ? r16 : perm16(r16);
    const int c0a = ((q ^ (ra_ >> 1)) & 7) << 3, c0b = ((q ^ (r16 >> 1)) & 7) << 3;
    const bf16_t* pa0; const bf16_t* pb0; int sta, stb;
    if (!SWAP) { pa0 = sB + (wa * (BN / 2)) * 64 + ra_ * 64; pb0 = sA + (wb * 64) * 64 + r16 * 64; sta = SB; stb = SA; }
    else       { pa0 = sA + (wa * 64) * 64 + ra_ * 64;       pb0 = sB + (wb * 64) * 64 + r16 * 64; sta = SA; stb = SB; }
    v4u ra0[4], rb0[NB_], ra1[4], rb1[NB_];
    g_load<NB_>(ra0, rb0, gA, lda, gB, ldb, 0);
    g_load<NB_>(ra1, rb1, gA, lda, gB, ldb, 1);
    s_store<NB_>(ra0, rb0, sA + soff, sB + soff);
    __syncthreads();
#pragma unroll 1
    for (int kt = 0; kt < nk - 2; kt += 2) {
        g_load<NB_>(ra0, rb0, gA, lda, gB, ldb, kt + 2);
        __builtin_amdgcn_sched_barrier(0);
        __builtin_amdgcn_s_setprio(1);
        mma_step<BN / 32>(acc, pa0, pb0, c0a, c0b);
        s_store<NB_>(ra1, rb1, sA + SA + soff, sB + SB + soff);
        __builtin_amdgcn_s_setprio(0);
        __syncthreads();
        g_load<NB_>(ra1, rb1, gA, lda, gB, ldb, kt + 3);
        __builtin_amdgcn_sched_barrier(0);
        __builtin_amdgcn_s_setprio(1);
        mma_step<BN / 32>(acc, pa0 + sta, pb0 + stb, c0a, c0b);
        s_store<NB_>(ra0, rb0, sA + soff, sB + soff);
        __builtin_amdgcn_s_setprio(0);
        __syncthreads();
    }
    mma_step<BN / 32>(acc, pa0, pb0, c0a, c0b);
    s_store<NB_>(ra1, rb1, sA + SA + soff, sB + SB + soff);
    __syncthreads();
    mma_step<BN / 32>(acc, pa0 + sta, pb0 + stb, c0a, c0b);
    __syncthreads();
}

template <int BN>
__device__ __forceinline__ void gemm_acc_lite(f32x4 (&acc)[BN / 32][4], const bf16_t* __restrict__ A, int lda, const bf16_t* __restrict__ Bt, int ldb,
                                              int K, unsigned char* smem) {
    constexpr int NB_ = BN / 32;
    constexpr int SA = 128 * 64, SB = BN * 64;
    bf16_t* sA = (bf16_t*)smem; bf16_t* sB = sA + 2 * SA;
    const int tid = opaque_tid(), lane = tid & 63, w = tid >> 6, r16 = lane & 15, q = lane >> 4;
    const int wa = w & 1, wb = w >> 1;
    const int nk = K >> 6;
    const bf16_t* gA = A + (size_t)(tid >> 3) * lda + (tid & 7) * 8;
    const bf16_t* gB = Bt + (size_t)(tid >> 3) * ldb + (tid & 7) * 8;
    const int soff = (tid >> 3) * 64 + (((tid & 7) ^ ((tid >> 4) & 7)) << 3);
    const int c0 = ((q ^ (r16 >> 1)) & 7) << 3;
    const bf16_t* pa0 = sB + (wa * (BN / 2)) * 64 + r16 * 64;
    const bf16_t* pb0 = sA + (wb * 64) * 64 + r16 * 64;
    v4u ra[4], rb[NB_];
    g_load<NB_>(ra, rb, gA, lda, gB, ldb, 0);
    s_store<NB_>(ra, rb, sA + soff, sB + soff);
    __syncthreads();
#pragma unroll 1
    for (int kt = 0; kt < nk - 2; kt += 2) {
        g_load<NB_>(ra, rb, gA, lda, gB, ldb, kt + 1);
        __builtin_amdgcn_sched_barrier(0);
        mma_step<BN / 32>(acc, pa0, pb0, c0);
        s_store<NB_>(ra, rb, sA + SA + soff, sB + SB + soff);
        __syncthreads();
        g_load<NB_>(ra, rb, gA, lda, gB, ldb, kt + 2);
        __builtin_amdgcn_sched_barrier(0);
        mma_step<BN / 32>(acc, pa0 + SB, pb0 + SA, c0);
        s_store<NB_>(ra, rb, sA + soff, sB + soff);
        __syncthreads();
    }
    g_load<NB_>(ra, rb, gA, lda, gB, ldb, nk - 1);
    __builtin_amdgcn_sched_barrier(0);
    mma_step<BN / 32>(acc, pa0, pb0, c0);
    s_store<NB_>(ra, rb, sA + SA + soff, sB + SB + soff);
    __syncthreads();
    mma_step<BN / 32>(acc, pa0 + SB, pb0 + SA, c0);
    __syncthreads();
}

__device__ __forceinline__ int swz32(int r) { return (0x78 >> (2 * ((r >> 2) & 3))) & 3; }
__device__ __forceinline__ void gemm_wide(f32x4 (&acc)[8][4], const bf16_t* __restrict__ A, int lda, const bf16_t* __restrict__ Bt, int ldb,
                                          int K, unsigned char* smem) {
    constexpr int SA = 128 * 32, SB = 256 * 32;
    bf16_t* sA = (bf16_t*)smem;
    bf16_t* sB = sA + 2 * SA;
    const int tid = opaque_tid(), lane = tid & 63, w = tid >> 6, r16 = lane & 15, q = lane >> 4;
    const int wa = w & 1, wb = w >> 1;
    const int nk = K >> 5;
    const int lrow = tid >> 2, lc = tid & 3;
    const bf16_t* gA = A + (size_t)lrow * lda + lc * 8;
    const bf16_t* gB = Bt + (size_t)lrow * ldb + lc * 8;
    const int soff = lrow * 32 + ((lc ^ swz32(lrow)) << 3);
    const int foff = r16 * 32 + ((q ^ swz32(r16)) << 3);
    const int pr_ = perm16(r16), foffp = pr_ * 32 + ((q ^ swz32(pr_)) << 3);
    const bf16_t* pa0 = sB + (wa * 128) * 32 + foffp;
    const bf16_t* pb0 = sA + (wb * 64) * 32 + foff;
    v4u ra[2], rb[4];
#pragma unroll
    for (int i = 0; i < 2; ++i) ra[i] = *(const v4u*)(gA + (size_t)(i * 64) * lda);
#pragma unroll
    for (int i = 0; i < 4; ++i) rb[i] = *(const v4u*)(gB + (size_t)(i * 64) * ldb);
#pragma unroll
    for (int i = 0; i < 2; ++i) *(v4u*)(sA + soff + i * 64 * 32) = ra[i];
#pragma unroll
    for (int i = 0; i < 4; ++i) *(v4u*)(sB + soff + i * 64 * 32) = rb[i];
    __syncthreads();
#pragma unroll 1
    for (int kt = 0; kt < nk; kt += 2) {
#pragma unroll
        for (int hf = 0; hf < 2; ++hf) {
            const int kn = (kt + hf + 1 < nk) ? kt + hf + 1 : kt + hf;
#pragma unroll
            for (int i = 0; i < 2; ++i) ra[i] = *(const v4u*)(gA + (size_t)(i * 64) * lda + kn * 32);
#pragma unroll
            for (int i = 0; i < 4; ++i) rb[i] = *(const v4u*)(gB + (size_t)(i * 64) * ldb + kn * 32);
            __builtin_amdgcn_sched_barrier(0);
            __builtin_amdgcn_s_setprio(1);
            {
                const bf16_t* pa = pa0 + hf * SB; const bf16_t* pb = pb0 + hf * SA;
                bf16x8 bfr[4];
#pragma unroll
                for (int j = 0; j < 4; ++j) bfr[j] = *(const bf16x8*)(pb + j * 16 * 32);
#pragma unroll
                for (int ih = 0; ih < 2; ++ih) {
                    bf16x8 af[4];
#pragma unroll
                    for (int i = 0; i < 4; ++i) af[i] = *(const bf16x8*)(pa + (ih * 4 + i) * 16 * 32);
#pragma unroll
                    for (int i = 0; i < 4; ++i)
#pragma unroll
                        for (int j = 0; j < 4; ++j) acc[ih * 4 + i][j] = MFMA(af[i], bfr[j], acc[ih * 4 + i][j]);
                }
            }
            __builtin_amdgcn_s_setprio(0);
            {
                bf16_t* dA = sA + (hf ^ 1) * SA + soff; bf16_t* dB = sB + (hf ^ 1) * SB + soff;
#pragma unroll
                for (int i = 0; i < 2; ++i) *(v4u*)(dA + i * 64 * 32) = ra[i];
#pragma unroll
                for (int i = 0; i < 4; ++i) *(v4u*)(dB + i * 64 * 32) = rb[i];
            }
            __syncthreads();
        }
    }
}

template <int NI>
__device__ __forceinline__ void zero_acc(f32x4 (&acc)[NI][4]) {
#pragma unroll
    for (int i = 0; i < NI; ++i)
#pragma unroll
        for (int j = 0; j < 4; ++j) acc[i][j] = (f32x4){0.f, 0.f, 0.f, 0.f};
}

__device__ __forceinline__ void transpose_group(const Params& p, unsigned char* smem, int grp) {
    unsigned char* ws = p.ws;
    const int tid = opaque_tid();
    float* tl = (float*)smem;
    {

            const int tile = grp * 4;
            const float* src; bf16_t* dst; int K, stride, col0, lt, ntn;
            if (tile < 512)       { src = p.in[3];  dst = (bf16_t*)(ws + OFF_W1);  K = 1024; stride = 6664; col0 = 0;    lt = tile;        ntn = 32; }
            else if (tile < 1664) { src = p.in[3];  dst = (bf16_t*)(ws + OFF_W1) + (size_t)2048 * 1024; K = 1024; stride = 6664; col0 = 2056; lt = tile - 512; ntn = 72; }
            else if (tile < 2432) { src = p.in[20]; dst = (bf16_t*)(ws + OFF_WG);  K = 1024; stride = 3072; col0 = 0; lt = tile - 1664; ntn = 48; }
            else if (tile < 2688) { src = p.in[22]; dst = (bf16_t*)(ws + OFF_WPM); K = 1024; stride = 1024; col0 = 0; lt = tile - 2432; ntn = 16; }
            else if (tile < 2944) { src = p.in[23]; dst = (bf16_t*)(ws + OFF_WPD); K = 1024; stride = 1024; col0 = 0; lt = tile - 2688; ntn = 16; }
            else if (tile < 3200) { src = p.in[24]; dst = (bf16_t*)(ws + OFF_WPC); K = 1024; stride = 1024; col0 = 0; lt = tile - 2944; ntn = 16; }
            else if (tile < 3456) { src = p.in[25]; dst = (bf16_t*)(ws + OFF_WOUT); K = 1024; stride = 1024; col0 = 0; lt = tile - 3200; ntn = 16; }
            else if (tile < 4480) { src = p.in[27]; dst = (bf16_t*)(ws + OFF_WUP); K = 1024; stride = 4096; col0 = 0; lt = tile - 3456; ntn = 64; }
            else if (tile < 5504) { src = p.in[28]; dst = (bf16_t*)(ws + OFF_WDN); K = 4096; stride = 1024; col0 = 0; lt = tile - 4480; ntn = 16; }
            else                  { src = p.in[19]; dst = (bf16_t*)(ws + OFF_WMKV); K = 1024; stride = 1536; col0 = 0; lt = tile - 5504; ntn = 24; }
            const bool scale_up = (tile >= 3456 && tile < 4480);
            const int tn = lt % ntn, tk = lt / ntn, n0 = tn * 64, k0 = tk * 64;
            const int kr = tid >> 4, n4 = (tid & 15) * 4;
            float4 v[4][4];
#pragma unroll
            for (int j = 0; j < 4; ++j)
#pragma unroll
                for (int i = 0; i < 4; ++i) v[j][i] = *(const float4*)(src + (size_t)(k0 + kr + 16 * i) * stride + col0 + n0 + j * 64 + n4);
            const int nn = tid >> 2, kq = tid & 3;
            float gs[16];
#pragma unroll
            for (int e = 0; e < 16; ++e) gs[e] = scale_up ? p.in[26][k0 + kq * 16 + e] : 1.0f;
#pragma unroll
            for (int j = 0; j < 4; ++j) {
                __syncthreads();
#pragma unroll
                for (int i = 0; i < 4; ++i) { float* d = tl + (kr + 16 * i) * 65 + n4; d[0] = v[j][i].x; d[1] = v[j][i].y; d[2] = v[j][i].z; d[3] = v[j][i].w; }
                __syncthreads();
                float f[16];
#pragma unroll
                for (int e = 0; e < 16; ++e) f[e] = tl[(kq * 16 + e) * 65 + nn] * gs[e];
                v4u o0, o1;
                o0.x = pack2(f[0], f[1]); o0.y = pack2(f[2], f[3]); o0.z = pack2(f[4], f[5]); o0.w = pack2(f[6], f[7]);
                o1.x = pack2(f[8], f[9]); o1.y = pack2(f[10], f[11]); o1.z = pack2(f[12], f[13]); o1.w = pack2(f[14], f[15]);
                bf16_t* dp = dst + (size_t)(n0 + j * 64 + nn) * K + k0 + kq * 16;
                *(v4u*)dp = o0; *(v4u*)(dp + 8) = o1;
            }
            }
}

__device__ void phase0(const Params& p, unsigned char* smem) {
    const int tid = opaque_tid(), lane = tid & 63, w = tid >> 6;
    unsigned char* ws = p.ws;
    {
        for (int k = blockIdx.x; k < 512; k += gridDim.x) transpose_group(p, smem, k < 416 ? k : 1376 + (k - 416));
        __syncthreads();
    }
    {
        float* sg = (float*)smem;
        const float* win = p.in[3];
#pragma unroll
        for (int i = 0; i < 8; ++i) { const int id = tid + i * 256, k = id >> 1, hf = id & 1; *(float4*)(sg + k * 8 + hf * 4) = *(const float4*)(win + (size_t)k * 6664 + 2048 + hf * 4); }
        __syncthreads();
        const float* g1 = p.in[2]; const float* gm = p.in[18];
        bf16_t* H = (bf16_t*)((unsigned char*)p.out + OUT_H);
        bf16_t* HM = (bf16_t*)(ws + OFF_HMEM);
        float* IG = (float*)(ws + OFF_IG); float* LF = (float*)(ws + OFF_LF);
        const int rstride = gridDim.x * 4;
        float4 vn[4], vn2[4];
        {
            const int row = blockIdx.x * 4 + w;
            const float* src = (row >= T_TOK) ? (p.in[1] + (size_t)(row - T_TOK) * 1024) : (p.in[0] + (size_t)row * 1024);
            const int row2 = (row + rstride < T_TOK + 1024) ? row + rstride : row;
            const float* src2 = (row2 >= T_TOK) ? (p.in[1] + (size_t)(row2 - T_TOK) * 1024) : (p.in[0] + (size_t)row2 * 1024);
#pragma unroll
            for (int i = 0; i < 4; ++i) { vn[i] = *(const float4*)(src + lane * 4 + 256 * i); vn2[i] = *(const float4*)(src2 + lane * 4 + 256 * i); }
        }
        for (int row = blockIdx.x * 4 + w; row < T_TOK + 1024; row += rstride) {
            const bool ismem = row >= T_TOK;
            const float* g = ismem ? gm : g1;
            bf16_t* dst = ismem ? (HM + (size_t)(row - T_TOK) * 1024) : (H + (size_t)row * 1024);
            float4 v[4]; float ss = 0.f;
#pragma unroll
            for (int i = 0; i < 4; ++i) { v[i] = vn[i]; vn[i] = vn2[i]; ss += v[i].x * v[i].x + v[i].y * v[i].y + v[i].z * v[i].z + v[i].w * v[i].w; }
            {
                const int rn = (row + 2 * rstride < T_TOK + 1024) ? row + 2 * rstride : row;
                const float* srcn = (rn >= T_TOK) ? (p.in[1] + (size_t)(rn - T_TOK) * 1024) : (p.in[0] + (size_t)rn * 1024);
#pragma unroll
                for (int i = 0; i < 4; ++i) vn2[i] = *(const float4*)(srcn + lane * 4 + 256 * i);
            }
            ss = wave_sum(ss);
            const float rstd = rsqrtf(ss * (1.0f / 1024.0f) + EPS);
            float ga[8];
#pragma unroll
            for (int c = 0; c < 8; ++c) ga[c] = 0.f;
#pragma unroll
            for (int i = 0; i < 4; ++i) {
                const int k = lane * 4 + 256 * i;
                const float4 gg = *(const float4*)(g + k);
                float hv[4] = {v[i].x * rstd * gg.x, v[i].y * rstd * gg.y, v[i].z * rstd * gg.z, v[i].w * rstd * gg.w};
                uint2 o; o.x = pack2(hv[0], hv[1]); o.y = pack2(hv[2], hv[3]);
                *(uint2*)(dst + k) = o;
                if (!ismem) {
#pragma unroll
                    for (int e = 0; e < 4; ++e) {
                        const float4 w0 = *(const float4*)(sg + (k + e) * 8), w1 = *(const float4*)(sg + (k + e) * 8 + 4);
                        ga[0] += hv[e] * w0.x; ga[1] += hv[e] * w0.y; ga[2] += hv[e] * w0.z; ga[3] += hv[e] * w0.w;
                        ga[4] += hv[e] * w1.x; ga[5] += hv[e] * w1.y; ga[6] += hv[e] * w1.z; ga[7] += hv[e] * w1.w;
                    }
                }
            }
            if (!ismem) {
#pragma unroll
                for (int c = 0; c < 8; ++c) ga[c] = wave_sum(ga[c]);
                if (lane == 0) {
#pragma unroll
                    for (int hd = 0; hd < 4; ++hd) {
                        IG[(size_t)row * 4 + hd] = ga[hd] + p.in[4][hd];
                        const float xf = ga[4 + hd] + p.in[5][hd];
                        LF[(size_t)row * 4 + hd] = fminf(xf, 0.f) - log1pf(__expf(-fabsf(xf)));
                    }
                }
            }
        }
    }
}

__device__ void phase1(const Params& p, unsigned char* smem) {
    unsigned char* ws = p.ws;
    const int tid = opaque_tid(), lane = tid & 63, w = tid >> 6, r16 = lane & 15, q = lane >> 4, wa = w & 1, wb = w >> 1;
    bf16_t* PROJ = (bf16_t*)(ws + OFF_PROJ);
    const bf16_t* H = (const bf16_t*)((unsigned char*)p.out + OUT_H);
    bf16_t* TMP = (bf16_t*)((unsigned char*)p.out + OUT_TMP);
    const int NT1 = 52, NTILES = 256 * NT1, NMEM = 8 * 12;
    for (int tile = blockIdx.x; tile < NTILES + NMEM; tile += gridDim.x) {
        f32x4 acc[4][4]; zero_acc<4>(acc);
        if (tile < NTILES) {
            int mt, nt; map_tile(tile, NT1, mt, nt);
            const int m0 = mt * 128, n0 = nt * 128;
            gemm_acc<128, false>(acc, H + (size_t)m0 * 1024, 1024, (const bf16_t*)(ws + OFF_W1) + (size_t)n0 * 1024, 1024, 1024, smem);
            const bool is_mv = (n0 >= C_MV && n0 < C_MO), is_dv = (n0 >= C_DV && n0 < C_CQ);
            if (!is_mv && !is_dv) {
                if (n0 >= C_DQ && n0 < C_DV) {
                    const bool isk = n0 >= C_DK;
                    const float* gn = isk ? p.in[10] : p.in[9];
                    const float sc = isk ? 1.0f : 0.125f * 1.4426950408889634f;
                    float gv[4][4];
#pragma unroll
                    for (int i = 0; i < 4; ++i) { const float4 g4 = *(const float4*)(gn + i * 16 + nq_of(q)); gv[i][0] = g4.x; gv[i][1] = g4.y; gv[i][2] = g4.z; gv[i][3] = g4.w; }
#pragma unroll
                    for (int j = 0; j < 4; ++j) {
                        float ss = 0.f;
#pragma unroll
                        for (int i = 0; i < 4; ++i) ss += acc[i][j][0] * acc[i][j][0] + acc[i][j][1] * acc[i][j][1] + acc[i][j][2] * acc[i][j][2] + acc[i][j][3] * acc[i][j][3];
                        ss += __shfl_xor(ss, 16); ss += __shfl_xor(ss, 32);
                        const float rs = rsqrtf(ss * (1.0f / 64.0f) + EPS) * sc;
#pragma unroll
                        for (int i = 0; i < 4; ++i) { acc[i][j][0] *= rs * gv[i][0]; acc[i][j][1] *= rs * gv[i][1]; acc[i][j][2] *= rs * gv[i][2]; acc[i][j][3] *= rs * gv[i][3]; }
                    }
                }
#pragma unroll
                for (int i = 0; i < 4; i += 2)
#pragma unroll
                    for (int j = 0; j < 4; ++j) {
                        const int n = n0 + wa * 64 + (i + (q >> 1)) * 16 + 8 * (q & 1), m = m0 + wb * 64 + j * 16 + r16;
                        unsigned ax = pack2(acc[i][j][0], acc[i][j][1]), ay = pack2(acc[i][j][2], acc[i][j][3]);
                        unsigned bx = pack2(acc[i + 1][j][0], acc[i + 1][j][1]), by = pack2(acc[i + 1][j][2], acc[i + 1][j][3]);
                        { auto r_ = __builtin_amdgcn_permlane32_swap(ax, bx, false, false); ax = r_[0]; bx = r_[1]; }
                        { auto r_ = __builtin_amdgcn_permlane32_swap(ay, by, false, false); ay = r_[0]; by = r_[1]; }
                        v4u o; o.x = ax; o.y = ay; o.z = bx; o.w = by;
                        if (n0 < 1024) *(v4u*)(TMP + (size_t)m * 1024 + n) = o;
                        else           *(v4u*)(PROJ + (size_t)m * LDP + n) = o;
                    }
            } else
#pragma unroll
            for (int i = 0; i < 4; ++i)
#pragma unroll
                for (int j = 0; j < 4; ++j) {
                    const int n = n0 + wa * 64 + i * 16 + nq_of(q), m = m0 + wb * 64 + j * 16 + r16;
                    const f32x4 a = acc[i][j];
                    if (is_mv) {
                        const int vv = (n - C_MV) & 255, hd = (n - C_MV) >> 8, mband = m & ~63, key = m & 63;
                        bf16_t* d = PROJ + (size_t)(mband + (vv >> 2)) * LDP + C_MV + hd * 256 + key;
                        d[0] = f2bf(a[0]); d[64] = f2bf(a[1]); d[128] = f2bf(a[2]); d[192] = f2bf(a[3]);
                    } else if (is_dv) {
                        const int vv = (n - C_DV) & 127, hd = (n - C_DV) >> 7, mband = m & ~63, key = m & 63;
                        bf16_t* d0 = PROJ + (size_t)(mband + (vv >> 1)) * LDP + C_DV + hd * 128 + key;
                        bf16_t* d1 = d0 + LDP;
                        d0[0] = f2bf(a[0]); d0[64] = f2bf(a[1]); d1[0] = f2bf(a[2]); d1[64] = f2bf(a[3]);
                    } else {
                        uint2 o; o.x = pack2(a[0], a[1]); o.y = pack2(a[2], a[3]);
                        if (n0 < 1024) *(uint2*)(TMP + (size_t)m * 1024 + n) = o;
                        else           *(uint2*)(PROJ + (size_t)m * LDP + n) = o;
                    }
                }
        } else {
            const int lt = tile - NTILES, mt = lt / 12, nt = lt % 12, m0 = mt * 128, n0 = nt * 128;
            gemm_acc<128, false>(acc, (const bf16_t*)(ws + OFF_HMEM) + (size_t)m0 * 1024, 1024, (const bf16_t*)(ws + OFF_WMKV) + (size_t)n0 * 1024, 1024, 1024, smem);
            bf16_t* MKN = (bf16_t*)(ws + OFF_MKN); bf16_t* VTC = (bf16_t*)(ws + OFF_VTC);
#pragma unroll
            for (int i = 0; i < 4; ++i)
#pragma unroll
                for (int j = 0; j < 4; ++j) {
                    const int n = n0 + wa * 64 + i * 16 + nq_of(q), m = m0 + wb * 64 + j * 16 + r16;
                    const f32x4 a = acc[i][j];
                    if (n0 < 512) { uint2 o; o.x = pack2(a[0], a[1]); o.y = pack2(a[2], a[3]); *(uint2*)(MKN + (size_t)m * 512 + n) = o; }
                    else {
                        const int vi = n - 512, hc = vi >> 8, v = vi & 255, b = m >> 8, mi = m & 255;
                        bf16_t* d = VTC + ((size_t)((b * 4 + hc) * 256 + v)) * 256 + mi;
                        d[0] = f2bf(a[0]); d[256] = f2bf(a[1]); d[512] = f2bf(a[2]); d[768] = f2bf(a[3]);
                    }
                }
        }
    }
    {
        const int nlate = (NTILES + NMEM) % (int)gridDim.x;
        const int nfree = (int)gridDim.x - nlate;
        if ((int)blockIdx.x >= nlate && nfree > 0) {
            for (int k = (int)blockIdx.x - nlate; k < 960; k += nfree) transpose_group(p, smem, 416 + k);
        } else if (nfree <= 0) {
            for (int k = blockIdx.x; k < 960; k += gridDim.x) transpose_group(p, smem, 416 + k);
        }
    }
}

template <int LANES>
__device__ __forceinline__ void norm_group(bf16_t* ptr, const float* gain, int sub, float scale) {
    uint4 v = *(const uint4*)ptr; float f[8]; unpack8(v, f);
    float ss = 0.f;
#pragma unroll
    for (int e = 0; e < 8; ++e) ss += f[e] * f[e];
#pragma unroll
    for (int m = 1; m < LANES; m <<= 1) ss += __shfl_xor(ss, m);
    const float rstd = rsqrtf(ss * (1.0f / (8 * LANES)) + EPS) * scale;
#pragma unroll
    for (int e = 0; e < 8; ++e) f[e] = f[e] * rstd * gain[sub * 8 + e];
    *(uint4*)ptr = pack8(f);
}

__device__ void phase2a(const Params& p, unsigned char* smem) {
    unsigned char* ws = p.ws;
    const int tid = opaque_tid(), lane = tid & 63, w = tid >> 6;
    bf16_t* PROJ = (bf16_t*)(ws + OFF_PROJ);
    const float* IG = (const float*)(ws + OFF_IG); const float* LF = (const float*)(ws + OFF_LF);
    float* BCUM = (float*)(ws + OFF_BCUM); float* MPREV = (float*)(ws + OFF_MPREV); float* MNEW = (float*)(ws + OFF_MNEW);
    {
        const int seq = blockIdx.x * 4 + w;
        if (seq < 16) {
            const int b = seq >> 2, hd = seq & 3;
            float m = 0.f;
            const size_t tb = ((size_t)(b * SEQ + 2 * lane)) * 4 + hd;
            float nl0 = LF[tb], nl1 = LF[tb + 4], ni0 = IG[tb], ni1 = IG[tb + 4];
#pragma unroll 1
            for (int c = 0; c < 64; ++c) {
                const float l0 = nl0, l1 = nl1, i0 = ni0, i1 = ni1;
                {
                    const size_t tn = tb + (size_t)((c < 63 ? c + 1 : c) * 128) * 4;
                    nl0 = LF[tn]; nl1 = LF[tn + 4]; ni0 = IG[tn]; ni1 = IG[tn + 4];
                }
                const float s = l0 + l1; float inc = s;
#pragma unroll
                for (int d = 1; d < 64; d <<= 1) { const float o = __shfl_up(inc, d); if (lane >= d) inc += o; }
                const float bc0 = inc - s + l0, bc1 = inc;
                BCUM[(size_t)seq * SEQ + c * 128 + 2 * lane] = bc0; BCUM[(size_t)seq * SEQ + c * 128 + 2 * lane + 1] = bc1;
                const float amax = wave_max(fmaxf(i0 - bc0, i1 - bc1));
                const float bend = __shfl(inc, 63);
                if (lane == 0) MPREV[seq * 64 + c] = m;
                m = bend + fmaxf(m, amax);
                if (lane == 0) MNEW[seq * 64 + c] = m;
            }
        }
    }
    const int nscan = gridDim.x > 8 ? 4 : 0;
    if ((int)blockIdx.x < nscan) return;
    const int gtid = ((int)blockIdx.x - nscan) * 256 + tid, gstride = ((int)gridDim.x - nscan) * 256;
    {
        const bf16_t* TMP = (const bf16_t*)((unsigned char*)p.out + OUT_TMP);
        const float* cw = p.in[6]; const float* cb = p.in[7];
        for (int idx = gtid; idx < T_TOK * 128; idx += gstride) {
            const int t = idx >> 7, c0 = (idx & 127) * 8, s = t & (SEQ - 1);
            float y[8];
#pragma unroll
            for (int e = 0; e < 8; ++e) y[e] = cb[c0 + e];
#pragma unroll
            for (int j = 0; j < 4; ++j) {
                if (s - 3 + j >= 0) {
                    const uint4 rv = *(const uint4*)(TMP + (size_t)(t - 3 + j) * 1024 + c0);
                    float f[8]; unpack8(rv, f);
#pragma unroll
                    for (int e = 0; e < 8; ++e) y[e] += f[e] * cw[j * 1024 + c0 + e];
                }
            }
            const float sc = (c0 < 512) ? 0.08838834764831845f : 1.0f;
#pragma unroll
            for (int e = 0; e < 8; ++e) y[e] = y[e] * sigmoidf_(y[e]) * sc;
            *(uint4*)(PROJ + (size_t)t * LDP + c0) = pack8(y);
        }
    }
    for (int idx = gtid; idx < T_TOK * 64; idx += gstride) {
        const int t = idx >> 6, cc = idx & 63, sub = cc & 15;
        norm_group<16>(PROJ + (size_t)t * LDP + C_CQ + cc * 8, p.in[16], sub, 0.08838834764831845f * 1.4426950408889634f);
    }
    {
        bf16_t* MKN = (bf16_t*)(ws + OFF_MKN);
        for (int idx = gtid; idx < 1024 * 64; idx += gstride) {
            const int r = idx >> 6, cc = idx & 63, sub = cc & 15;
            norm_group<16>(MKN + (size_t)r * 512 + cc * 8, p.in[17], sub, 1.0f);
        }
    }
}

__device__ void phase2b(const Params& p, unsigned char* smem) {
    unsigned char* ws = p.ws;
    const int tid = opaque_tid(), lane = tid & 63, w = tid >> 6, r16 = lane & 15, q = lane >> 4, wa = w & 1, wb = w >> 1;
    const bf16_t* PROJ = (const bf16_t*)(ws + OFF_PROJ);
    const float* IG = (const float*)(ws + OFF_IG); const float* BCUM = (const float*)(ws + OFF_BCUM); const float* MNEW = (const float*)(ws + OFF_MNEW);
    bf16_t* CST = (bf16_t*)((unsigned char*)p.out + OUT_TMP); float* NST = (float*)(ws + OFF_NST);
    bf16_t* sV = (bf16_t*)smem; bf16_t* sK = sV + 128 * 136; float* sw = (float*)(smem + 69632);
    for (int task = blockIdx.x; task < 2048; task += gridDim.x) {
        const int tid = opaque_tid(), lane = tid & 63, w = tid >> 6, r16 = lane & 15, q = lane >> 4, wa = w & 1, wb = w >> 1;
        const int vh = task & 1, bhc = task >> 1, c = bhc & 63, bh = bhc >> 6, hd = bh & 3, b = bh >> 2, t0 = b * SEQ + c * 128;
        __syncthreads();
        if (tid < 128) {
            const float bc = BCUM[(size_t)bh * SEQ + c * 128 + tid], bend = BCUM[(size_t)bh * SEQ + c * 128 + 127];
            sw[tid] = __expf(bend - bc + IG[(size_t)(t0 + tid) * 4 + hd] - MNEW[bhc]);
        }
        __syncthreads();
#pragma unroll
        for (int i = 0; i < 8; ++i) {
            const int id = tid + i * 256, bb = id >> 10, rr = (id >> 5) & 31, cc = id & 31;
            const int r = vh * 32 + rr, vv = 4 * rr + (cc >> 3), key = bb * 64 + (cc & 7) * 8;
            *(uint4*)(sV + vv * 136 + key) = *(const uint4*)(PROJ + (size_t)(t0 + bb * 64 + r) * LDP + C_MV + hd * 256 + cc * 8);
        }
#pragma unroll
        for (int i = 0; i < 8; ++i) {
            const int id = tid + i * 256, s = id >> 4, cc = id & 15;
            const uint4 kv = *(const uint4*)(PROJ + (size_t)(t0 + s) * LDP + C_MK + hd * 128 + cc * 8);
            float f[8]; unpack8(kv, f); const float ww = sw[s];
#pragma unroll
            for (int e = 0; e < 8; ++e) sK[(cc * 8 + e) * 136 + s] = f2bf(f[e] * ww);
        }
        __syncthreads();
        f32x4 acc[4][4]; zero_acc<4>(acc);
#pragma unroll
        for (int ks = 0; ks < 4; ++ks) {
            bf16x8 af[4], bfr[4];
#pragma unroll
            for (int i = 0; i < 4; ++i) af[i] = *(const bf16x8*)(sK + (wa * 64 + i * 16 + r16) * 136 + ks * 32 + q * 8);
#pragma unroll
            for (int j = 0; j < 4; ++j) bfr[j] = *(const bf16x8*)(sV + (wb * 64 + j * 16 + r16) * 136 + ks * 32 + q * 8);
#pragma unroll
            for (int i = 0; i < 4; ++i)
#pragma unroll
                for (int j = 0; j < 4; ++j) acc[i][j] = MFMA(af[i], bfr[j], acc[i][j]);
        }
#pragma unroll
        for (int i = 0; i < 4; ++i)
#pragma unroll
            for (int j = 0; j < 4; ++j) {
                const int d = wa * 64 + i * 16 + 4 * q, v = vh * 128 + wb * 64 + j * 16 + r16;
                uint2 o; o.x = pack2(acc[i][j][0], acc[i][j][1]); o.y = pack2(acc[i][j][2], acc[i][j][3]);
                *(uint2*)(CST + ((size_t)bhc * 256 + v) * 128 + d) = o;
            }
        if (vh == 0 && tid < 128) {
            float sm = 0.f;
#pragma unroll
            for (int s8 = 0; s8 < 16; ++s8) {
                const uint4 kv = *(const uint4*)(sK + tid * 136 + s8 * 8); float f[8]; unpack8(kv, f);
                sm += ((f[0] + f[1]) + (f[2] + f[3])) + ((f[4] + f[5]) + (f[6] + f[7]));
            }
            NST[(size_t)bhc * 128 + tid] = sm;
        }
    }
}

__device__ void phase2c(const Params& p) {
    unsigned char* ws = p.ws;
    const float* BCUM = (const float*)(ws + OFF_BCUM); const float* MPREV = (const float*)(ws + OFF_MPREV); const float* MNEW = (const float*)(ws + OFF_MNEW);
    bf16_t* CST = (bf16_t*)((unsigned char*)p.out + OUT_TMP); float* NST = (float*)(ws + OFF_NST);
    const int gtid = blockIdx.x * 256 + threadIdx.x, gstride = gridDim.x * 256;
    for (int idx = gtid; idx < 16 * 4096 + 16 * 128; idx += gstride) {
        if (idx < 16 * 4096) {
            const int bh = idx >> 12, e8 = idx & 4095;
            float st[8];
#pragma unroll
            for (int e = 0; e < 8; ++e) st[e] = 0.f;
#pragma unroll 4
            for (int c = 0; c < 64; ++c) {
                const int bhc = bh * 64 + c;
                uint4* ptr = (uint4*)(CST + (size_t)bhc * 32768 + e8 * 8);
                const uint4 dv = *ptr; float f[8]; unpack8(dv, f);
                *ptr = pack8(st);
                const float decay = __expf(BCUM[(size_t)bh * SEQ + c * 128 + 127] + MPREV[bhc] - MNEW[bhc]);
#pragma unroll
                for (int e = 0; e < 8; ++e) st[e] = decay * st[e] + f[e];
            }
        } else {
            const int i2 = idx - 16 * 4096, bh = i2 >> 7, d = i2 & 127;
            float st = 0.f;
            for (int c = 0; c < 64; ++c) {
                const int bhc = bh * 64 + c;
                float* ptr = NST + (size_t)bhc * 128 + d;
                const float dn = *ptr; *ptr = st;
                const float decay = __expf(BCUM[(size_t)bh * SEQ + c * 128 + 127] + MPREV[bhc] - MNEW[bhc]);
                st = decay * st + dn;
            }
        }
    }
}

__device__ void phase2d(const Params& p, unsigned char* smem) {
    unsigned char* ws = p.ws;
    const int tid = opaque_tid(), lane = tid & 63, w = tid >> 6, r16 = lane & 15, q = lane >> 4;
    bf16_t* PROJ = (bf16_t*)(ws + OFF_PROJ);
    const float* IG = (const float*)(ws + OFF_IG); const float* BCUM = (const float*)(ws + OFF_BCUM); const float* MPREV = (const float*)(ws + OFF_MPREV);
    const bf16_t* CST = (const bf16_t*)((unsigned char*)p.out + OUT_TMP); const float* NST = (const float*)(ws + OFF_NST);
    const float* gmn = p.in[8];
    bf16_t* sQ = (bf16_t*)smem; bf16_t* sK = sQ + 128 * 136;
    float* aS = (float*)(smem + 69632); float* Mj = aS + 128; float* bcS = Mj + 128; float* nS = bcS + 128;
    for (int task = blockIdx.x; task < 1024; task += gridDim.x) {
        const int tid = opaque_tid(), lane = tid & 63, w = tid >> 6, r16 = lane & 15, q = lane >> 4;
        const int bhc = task, c = bhc & 63, bh = bhc >> 6, hd = bh & 3, b = bh >> 2, t0 = b * SEQ + c * 128;
        const float mprev = MPREV[bhc];
        __syncthreads();
        if (tid < 128) {
            const float bc = BCUM[(size_t)bh * SEQ + c * 128 + tid];
            aS[tid] = IG[(size_t)(t0 + tid) * 4 + hd] - bc; bcS[tid] = bc; nS[tid] = NST[(size_t)bhc * 128 + tid];
        }
#pragma unroll
        for (int i = 0; i < 8; ++i) {
            const int id = tid + i * 256, row = id >> 4, cc = id & 15;
            *(uint4*)(sQ + row * 136 + cc * 8) = *(const uint4*)(PROJ + (size_t)(t0 + row) * LDP + C_MQ + hd * 128 + cc * 8);
            *(uint4*)(sK + row * 136 + cc * 8) = *(const uint4*)(PROJ + (size_t)(t0 + row) * LDP + C_MK + hd * 128 + cc * 8);
        }
        __syncthreads();
        if (tid < 128) {
            float pm = -3.0e38f;
            const int nfull = (tid + 1) >> 2;
            for (int s4 = 0; s4 < nfull; ++s4) { const float4 a4 = *(const float4*)(aS + 4 * s4); pm = fmaxf(fmaxf(pm, fmaxf(a4.x, a4.y)), fmaxf(a4.z, a4.w)); }
            for (int s = 4 * nfull; s <= tid; ++s) pm = fmaxf(pm, aS[s]);
            Mj[tid] = fmaxf(mprev, pm);
        }
        __syncthreads();
        bf16x8 fS[2][4], fQ[2][4];
        float dsum[2] = {0.f, 0.f}, qn[2] = {0.f, 0.f}, Ml[2];
        Ml[0] = Mj[32 * w + r16]; Ml[1] = Mj[32 * w + 16 + r16];
#pragma unroll
        for (int kp = 0; kp < 4; ++kp) {
            f32x4 sa[2][2];
#pragma unroll
            for (int hf = 0; hf < 2; ++hf) { sa[hf][0] = (f32x4){0.f, 0.f, 0.f, 0.f}; sa[hf][1] = (f32x4){0.f, 0.f, 0.f, 0.f}; }
#pragma unroll
            for (int ks = 0; ks < 4; ++ks) {
                const bf16x8 q0 = *(const bf16x8*)(sQ + (32 * w + r16) * 136 + ks * 32 + q * 8);
                const bf16x8 q1 = *(const bf16x8*)(sQ + (32 * w + 16 + r16) * 136 + ks * 32 + q * 8);
#pragma unroll
                for (int hf = 0; hf < 2; ++hf) {
                    const bf16x8 kf = *(const bf16x8*)(sK + ((2 * kp + hf) * 16 + r16) * 136 + ks * 32 + q * 8);
                    sa[hf][0] = MFMA(kf, q0, sa[hf][0]); sa[hf][1] = MFMA(kf, q1, sa[hf][1]);
                }
            }
#pragma unroll
            for (int hf = 0; hf < 2; ++hf)
#pragma unroll
                for (int jt = 0; jt < 2; ++jt)
#pragma unroll
                    for (int rr = 0; rr < 4; ++rr) {
                        const int s = (2 * kp + hf) * 16 + 4 * q + rr, j = 32 * w + 16 * jt + r16;
                        const float val = (s <= j) ? sa[hf][jt][rr] * __expf(aS[s] - Ml[jt]) : 0.f;
                        dsum[jt] += val;
                        fS[jt][kp][hf * 4 + rr] = (short)f2bf(val);
                    }
            __builtin_amdgcn_sched_barrier(0);
        }
        float rden[2];
#pragma unroll
        for (int jt = 0; jt < 2; ++jt) {
            const float wi = __expf(mprev - Ml[jt]);
#pragma unroll
            for (int ks = 0; ks < 4; ++ks) {
                const bf16x8 qf = *(const bf16x8*)(sQ + (32 * w + 16 * jt + r16) * 136 + ks * 32 + q * 8);
#pragma unroll
                for (int e = 0; e < 8; ++e) {
                    const float f = bf2f((bf16_t)qf[e]) * wi;
                    qn[jt] += f * nS[ks * 32 + q * 8 + e];
                    fQ[jt][ks][e] = (short)f2bf(f);
                }
            }
            float den = dsum[jt] + qn[jt];
            den += __shfl_xor(den, 16); den += __shfl_xor(den, 32);
            const float mloc = bcS[32 * w + 16 * jt + r16] + Ml[jt];
            rden[jt] = 1.0f / fmaxf(fabsf(den), __expf(-mloc));
        }
        float ssq[2] = {0.f, 0.f};
#pragma unroll 1
        for (int vq = 0; vq < 4; ++vq) {
            __syncthreads();
#pragma unroll
            for (int i = 0; i < 4; ++i) {
                const int id = tid + i * 256, bb = id >> 9, rr = (id >> 5) & 15, cc = id & 31;
                const int r = vq * 16 + rr, vv = 4 * rr + (cc >> 3), key = bb * 64 + (cc & 7) * 8;
                *(uint4*)(sQ + vv * 136 + key) = *(const uint4*)(PROJ + (size_t)(t0 + bb * 64 + r) * LDP + C_MV + hd * 256 + cc * 8);
            }
#pragma unroll
            for (int i = 0; i < 4; ++i) {
                const int id = tid + i * 256, vv = id >> 4, cc = id & 15;
                *(uint4*)(sK + vv * 136 + cc * 8) = *(const uint4*)(CST + ((size_t)bhc * 256 + vq * 64 + vv) * 128 + cc * 8);
            }
            __syncthreads();
#pragma unroll
            for (int vt = 0; vt < 4; ++vt) {
                f32x4 o[2]; o[0] = (f32x4){0.f, 0.f, 0.f, 0.f}; o[1] = (f32x4){0.f, 0.f, 0.f, 0.f};
#pragma unroll
                for (int kp = 0; kp < 4; ++kp) {
                    const bf16_t* vp = sQ + (vt * 16 + r16) * 136 + kp * 32 + 4 * q;
                    const uint2 lo = *(const uint2*)vp, hi = *(const uint2*)(vp + 16);
                    uint4 cm; cm.x = lo.x; cm.y = lo.y; cm.z = hi.x; cm.w = hi.y;
                    const bf16x8 vf = *(const bf16x8*)&cm;
                    o[0] = MFMA(vf, fS[0][kp], o[0]); o[1] = MFMA(vf, fS[1][kp], o[1]);
                }
#pragma unroll
                for (int ks = 0; ks < 4; ++ks) {
                    const bf16x8 cf = *(const bf16x8*)(sK + (vt * 16 + r16) * 136 + ks * 32 + q * 8);
                    o[0] = MFMA(cf, fQ[0][ks], o[0]); o[1] = MFMA(cf, fQ[1][ks], o[1]);
                }
                const int v0 = vq * 64 + vt * 16 + 4 * q;
                const float4 gg = *(const float4*)(gmn + hd * 256 + v0);
#pragma unroll
                for (int jt = 0; jt < 2; ++jt) {
                    bf16_t* ptr = PROJ + (size_t)(t0 + 32 * w + 16 * jt + r16) * LDP + C_MO + hd * 256 + v0;
                    const uint2 mo = *(const uint2*)ptr;
                    const float m0 = __uint_as_float(mo.x << 16), m1 = __uint_as_float(mo.x & 0xffff0000u), m2 = __uint_as_float(mo.y << 16), m3 = __uint_as_float(mo.y & 0xffff0000u);
                    const float h0 = o[jt][0] * rden[jt], h1 = o[jt][1] * rden[jt], h2 = o[jt][2] * rden[jt], h3 = o[jt][3] * rden[jt];
                    ssq[jt] += h0 * h0 + h1 * h1 + h2 * h2 + h3 * h3;
                    uint2 ov; ov.x = pack2(sigmoidf_(m0) * h0 * gg.x, sigmoidf_(m1) * h1 * gg.y); ov.y = pack2(sigmoidf_(m2) * h2 * gg.z, sigmoidf_(m3) * h3 * gg.w);
                    *(uint2*)ptr = ov;
                }
            }
        }
#pragma unroll
        for (int jt = 0; jt < 2; ++jt) {
            float s2 = ssq[jt]; s2 += __shfl_xor(s2, 16); s2 += __shfl_xor(s2, 32);
            const float rstd = rsqrtf(s2 * (1.0f / 256.0f) + EPS);
#pragma unroll 2
            for (int vv = 0; vv < 16; ++vv) {
                bf16_t* ptr = PROJ + (size_t)(t0 + 32 * w + 16 * jt + r16) * LDP + C_MO + hd * 256 + vv * 16 + 4 * q;
                const uint2 yv = *(const uint2*)ptr;
                uint2 ov;
                ov.x = pack2(__uint_as_float(yv.x << 16) * rstd, __uint_as_float(yv.x & 0xffff0000u) * rstd);
                ov.y = pack2(__uint_as_float(yv.y << 16) * rstd, __uint_as_float(yv.y & 0xffff0000u) * rstd);
                *(uint2*)ptr = ov;
            }
        }
    }
}

__device__ __forceinline__ unsigned cvt_pk_bf16(float lo, float hi) { return pack2(lo, hi); }
typedef unsigned u32x4 __attribute__((ext_vector_type(4)));
template <int DK>
__device__ __forceinline__ void qk_tile(f32x4 (&s)[2][2], const bf16_t* sQw, const bf16_t* sKt, int coff, int r16, int q, float init) {
    const f32x4 initv = (f32x4){init, init, init, init};
#pragma unroll
    for (int ks = 0; ks < DK / 32; ++ks) {
        const bf16x8 q0 = *(const bf16x8*)(sQw + r16 * 136 + coff + ks * 32 + q * 8);
        const bf16x8 q1 = *(const bf16x8*)(sQw + (16 + r16) * 136 + coff + ks * 32 + q * 8);
#pragma unroll
        for (int st = 0; st < 2; ++st) {
            const bf16x8 kf = *(const bf16x8*)(sKt + (st * 16 + r16) * 136 + coff + ks * 32 + q * 8);
            s[st][0] = MFMA(kf, q0, ks == 0 ? initv : s[st][0]); s[st][1] = MFMA(kf, q1, ks == 0 ? initv : s[st][1]);
        }
    }
}
template <bool MASK>
__device__ __forceinline__ void make_p(bf16x8 (&pf)[2], const f32x4 (&s)[2][2], int key0  , int qpos0  ) {
#pragma unroll
    for (int jt = 0; jt < 2; ++jt) {
        float e[8];
#pragma unroll
        for (int st = 0; st < 2; ++st)
#pragma unroll
            for (int rr = 0; rr < 4; ++rr) {
                float v = __builtin_amdgcn_exp2f(s[st][jt][rr]);
                if (MASK) v = (key0 + st * 16 + rr <= qpos0 + 16 * jt) ? v : 0.f;
                e[st * 4 + rr] = v;
            }
        u32x4 pk; pk.x = cvt_pk_bf16(e[0], e[1]); pk.y = cvt_pk_bf16(e[2], e[3]); pk.z = cvt_pk_bf16(e[4], e[5]); pk.w = cvt_pk_bf16(e[6], e[7]);
        pf[jt] = *(const bf16x8*)&pk;
    }
}
__device__ __forceinline__ bf16x8 load_vfrag(const bf16_t* sVt, int vt, int kp, int r16, int q) {
    const bf16_t* vp = sVt + (vt * 16 + r16) * 72 + kp * 32 + 4 * q;
    const uint2 lo = *(const uint2*)vp, hi = *(const uint2*)(vp + 16);
    u32x4 cm; cm.x = lo.x; cm.y = lo.y; cm.z = hi.x; cm.w = hi.y;
    return *(const bf16x8*)&cm;
}
__device__ __forceinline__ bf16x8 ones_frag() { u32x4 o; o.x = o.y = o.z = o.w = 0x3f803f80u; return *(const bf16x8*)&o; }

template <bool MASK>
__device__ __forceinline__ void diff_tile(f32x4 (&O)[8][2], f32x4 (&L)[2], const bf16_t* sQw, const bf16_t* sK, const bf16_t* sVt,
                                          int r16, int q, float init, int key0, int qpos0) {
    const bf16x8 ones = ones_frag();
#pragma unroll
    for (int kp = 0; kp < 2; ++kp) {
        f32x4 s[2][2];
        const f32x4 initv = (f32x4){init, init, init, init};
#pragma unroll
        for (int ks = 0; ks < 2; ++ks) {
            const bf16x8 q0 = *(const bf16x8*)(sQw + r16 * 72 + ks * 32 + q * 8);
            const bf16x8 q1 = *(const bf16x8*)(sQw + (16 + r16) * 72 + ks * 32 + q * 8);
#pragma unroll
            for (int st = 0; st < 2; ++st) {
                const bf16x8 kf = *(const bf16x8*)(sK + (kp * 32 + st * 16 + r16) * 72 + ks * 32 + q * 8);
                s[st][0] = MFMA(kf, q0, ks == 0 ? initv : s[st][0]); s[st][1] = MFMA(kf, q1, ks == 0 ? initv : s[st][1]);
            }
        }
        bf16x8 pf[2];
        make_p<MASK>(pf, s, key0 + kp * 32, qpos0);
        __builtin_amdgcn_sched_barrier(0);
        __builtin_amdgcn_s_setprio(1);
        L[0] = MFMA(ones, pf[0], L[0]); L[1] = MFMA(ones, pf[1], L[1]);
#pragma unroll
        for (int vt = 0; vt < 8; ++vt) {
            const bf16x8 vf = load_vfrag(sVt, vt, kp, r16, q);
            O[vt][0] = MFMA(vf, pf[0], O[vt][0]); O[vt][1] = MFMA(vf, pf[1], O[vt][1]);
            if (vt == 3) __builtin_amdgcn_sched_barrier(0);
        }
        __builtin_amdgcn_s_setprio(0);
        __builtin_amdgcn_sched_barrier(0);
    }
}

__device__ __forceinline__ void diff_pass(f32x4 (&O)[8][2], f32x4 (&L)[2], const v4u (&qreg)[4], const bf16_t* PROJ, unsigned char* smem, int comp, int b, int hd, int qb, float init) {
    const int tid = opaque_tid(), lane = tid & 63, w = tid >> 6, r16 = lane & 15, q = lane >> 4;
    constexpr int SKB = 64 * 72, SVB = 128 * 72;
    bf16_t* sKb = (bf16_t*)smem;
    bf16_t* sVb = sKb + 2 * SKB;
    bf16_t* sQc = sVb + 2 * SVB;
#pragma unroll
    for (int vt = 0; vt < 8; ++vt) { O[vt][0] = O[vt][1] = (f32x4){0.f, 0.f, 0.f, 0.f}; }
    L[0] = L[1] = (f32x4){0.f, 0.f, 0.f, 0.f};
    const int nkt = 2 * qb + 2;
    const int qpos0 = qb * 128 + 32 * w + r16;
    const int krow = tid >> 3, kcc = tid & 7;
    const int vrow = tid >> 4, vcc = tid & 15;
    const bf16_t* gK = PROJ + (size_t)(b * SEQ + krow) * LDP + C_DK + hd * 128 + comp * 64 + kcc * 8;
    const bf16_t* gV = PROJ + (size_t)(b * SEQ + vrow) * LDP + C_DV + hd * 128 + vcc * 8;
    v4u rk[2], rv[4];
    rk[0] = *(const v4u*)gK; rk[1] = *(const v4u*)(gK + (size_t)32 * LDP);
#pragma unroll
    for (int i = 0; i < 4; ++i) rv[i] = *(const v4u*)(gV + (size_t)(16 * i) * LDP);
    __syncthreads();
#pragma unroll
    for (int i = 0; i < 4; ++i) *(v4u*)(sQc + (krow + 32 * i) * 72 + kcc * 8) = qreg[i];
    *(v4u*)(sKb + krow * 72 + kcc * 8) = rk[0]; *(v4u*)(sKb + (krow + 32) * 72 + kcc * 8) = rk[1];
#pragma unroll
    for (int i = 0; i < 4; ++i) *(v4u*)(sVb + (2 * (vrow + 16 * i) + (vcc >> 3)) * 72 + (vcc & 7) * 8) = rv[i];
    __syncthreads();
#pragma unroll 1
    for (int kt = 0; kt < nkt; ++kt) {
        const int cur = kt & 1;
        {
            const int kn = (kt + 1 < nkt) ? kt + 1 : kt;
            const size_t off = (size_t)kn * 64 * LDP;
            rk[0] = *(const v4u*)(gK + off); rk[1] = *(const v4u*)(gK + off + (size_t)32 * LDP);
#pragma unroll
            for (int i = 0; i < 4; ++i) rv[i] = *(const v4u*)(gV + off + (size_t)(16 * i) * LDP);
        }
        __builtin_amdgcn_sched_barrier(0);
        if (kt < 2 * qb) diff_tile<false>(O, L, sQc + (32 * w) * 72, sKb + cur * SKB, sVb + cur * SVB, r16, q, init, 0, 0);
        else             diff_tile<true>(O, L, sQc + (32 * w) * 72, sKb + cur * SKB, sVb + cur * SVB, r16, q, init, kt * 64 + 4 * q, qpos0);
        {
            bf16_t* dk = sKb + (cur ^ 1) * SKB; bf16_t* dv = sVb + (cur ^ 1) * SVB;
            *(v4u*)(dk + krow * 72 + kcc * 8) = rk[0]; *(v4u*)(dk + (krow + 32) * 72 + kcc * 8) = rk[1];
#pragma unroll
            for (int i = 0; i < 4; ++i) *(v4u*)(dv + (2 * (vrow + 16 * i) + (vcc >> 3)) * 72 + (vcc & 7) * 8) = rv[i];
        }
        __syncthreads();
    }
}

__device__ void phase3(const Params& p, unsigned char* smem, int* s_task) {
    unsigned char* ws = p.ws;
    const int tid = opaque_tid(), lane = tid & 63, w = tid >> 6, r16 = lane & 15, q = lane >> 4;
    bf16_t* PROJ = (bf16_t*)(ws + OFF_PROJ);
    unsigned* ctr = (unsigned*)(ws + OFF_CTR);
    const float l1 = wave_sum(p.in[11][lane] * p.in[12][lane]), l2 = wave_sum(p.in[13][lane] * p.in[14][lane]);
    const float gq = wave_max(fabsf(p.in[9][lane])), gk = wave_max(fabsf(p.in[10][lane]));
    const float lam = __expf(l1) - __expf(l2) + 0.2f;
    const float init = -8.0f * gq * gk * 1.4426950408889634f;
    const float* sg = p.in[15];
    while (true) {
        __syncthreads();
        const int xcd = blockIdx.x & 7;
        if (tid == 0) *s_task = (int)atomicAdd(ctr + 8 + xcd, 1u);
        __syncthreads();
        const int task = *s_task;
        if (task >= 256) break;
        const int lane = opaque_tid() & 63, w = opaque_tid() >> 6, r16 = lane & 15, q = lane >> 4;
        const int qb = 63 - (task & 63), bh = xcd + 8 * (task >> 6), hd = bh & 7, b = bh >> 3, tq0 = b * SEQ + qb * 128;
        f32x4 O[8][2], L[2];
        v4u qreg[4];
        const int tid2 = opaque_tid();
        const bf16_t* gQ = PROJ + (size_t)(tq0 + (tid2 >> 3)) * LDP + C_DQ + hd * 128 + (tid2 & 7) * 8;
        bf16_t* yrow0 = PROJ + (size_t)(tq0 + 32 * w + r16) * LDP + C_DQ + hd * 128;
#pragma unroll
        for (int i = 0; i < 4; ++i) qreg[i] = *(const v4u*)(gQ + (size_t)(32 * i) * LDP);
        diff_pass(O, L, qreg, PROJ, smem, 0, b, hd, qb, init);
#pragma unroll
        for (int i = 0; i < 4; ++i) qreg[i] = *(const v4u*)(gQ + (size_t)(32 * i) * LDP + 64);
        asm volatile("s_waitcnt vmcnt(0)" ::: "memory");
        __syncthreads();
#pragma unroll
        for (int jt = 0; jt < 2; ++jt) {
            const float r1 = 1.0f / L[jt][0];
#pragma unroll
            for (int vt = 0; vt < 8; ++vt) {
                uint2 ov; ov.x = cvt_pk_bf16(O[vt][jt][0] * r1, O[vt][jt][1] * r1); ov.y = cvt_pk_bf16(O[vt][jt][2] * r1, O[vt][jt][3] * r1);
                *(uint2*)(yrow0 + (size_t)(16 * jt) * LDP + vt * 16 + 4 * q) = ov;
            }
        }
        diff_pass(O, L, qreg, PROJ, smem, 1, b, hd, qb, init);
#pragma unroll
        for (int jt = 0; jt < 2; ++jt) {
            const float r2 = lam / L[jt][0];
            float ss = 0.f;
#pragma unroll
            for (int vt = 0; vt < 8; ++vt) {
                const uint2 sv = *(const uint2*)(yrow0 + (size_t)(16 * jt) * LDP + vt * 16 + 4 * q);
                const float a0 = __uint_as_float(sv.x << 16), a1 = __uint_as_float(sv.x & 0xffff0000u);
                const float a2 = __uint_as_float(sv.y << 16), a3 = __uint_as_float(sv.y & 0xffff0000u);
                const float o0 = a0 - O[vt][jt][0] * r2, o1 = a1 - O[vt][jt][1] * r2, o2 = a2 - O[vt][jt][2] * r2, o3 = a3 - O[vt][jt][3] * r2;
                O[vt][jt][0] = o0; O[vt][jt][1] = o1; O[vt][jt][2] = o2; O[vt][jt][3] = o3;
                ss += o0 * o0 + o1 * o1 + o2 * o2 + o3 * o3;
            }
            ss += __shfl_xor(ss, 16); ss += __shfl_xor(ss, 32);
            const float rstd = rsqrtf(ss * (1.0f / 128.0f) + EPS) * 0.8f;
#pragma unroll
            for (int vt = 0; vt < 8; ++vt) {
                const int v0 = vt * 16 + 4 * q;
                const float4 gg = *(const float4*)(sg + v0);
                uint2 ov; ov.x = cvt_pk_bf16(O[vt][jt][0] * rstd * gg.x, O[vt][jt][1] * rstd * gg.y); ov.y = cvt_pk_bf16(O[vt][jt][2] * rstd * gg.z, O[vt][jt][3] * rstd * gg.w);
                *(uint2*)(PROJ + (size_t)(tq0 + 32 * w + 16 * jt + r16) * LDP + C_DQ + hd * 128 + v0) = ov;
            }
        }
    }
}

__device__ void phase4(const Params& p, unsigned char* smem) {
    unsigned char* ws = p.ws;
    const int tid = opaque_tid(), lane = tid & 63, w = tid >> 6, r16 = lane & 15, q = lane >> 4;
    bf16_t* PROJ = (bf16_t*)(ws + OFF_PROJ);
    const bf16_t* MKN = (const bf16_t*)(ws + OFF_MKN); const bf16_t* VTC = (const bf16_t*)(ws + OFF_VTC);
    bf16_t* sQ = (bf16_t*)smem; bf16_t* sK = sQ + 128 * 136; bf16_t* sVt = sK + 64 * 136;
    const float gq = wave_max(fmaxf(fabsf(p.in[16][lane]), fabsf(p.in[16][lane + 64])));
    const float gk = wave_max(fmaxf(fabsf(p.in[17][lane]), fabsf(p.in[17][lane + 64])));
    const float init = -11.313708498984761f * gq * gk * 1.4426950408889634f;
    const bf16x8 ones = ones_frag();
    for (int task = blockIdx.x; task < 2048; task += gridDim.x) {
        const int tid = opaque_tid(), lane = tid & 63, w = tid >> 6, r16 = lane & 15, q = lane >> 4;
        const int vhalf = task & 1, qt = (task >> 1) & 63, bh = task >> 7, hc = bh & 3, b = bh >> 2, tq0 = b * SEQ + qt * 128;
        __syncthreads();
#pragma unroll
        for (int i = 0; i < 8; ++i) {
            const int id = tid + i * 256, row = id >> 4, cc = id & 15;
            *(uint4*)(sQ + row * 136 + cc * 8) = *(const uint4*)(PROJ + (size_t)(tq0 + row) * LDP + C_CQ + hc * 128 + cc * 8);
        }
        f32x4 O[8][2], L[2];
#pragma unroll
        for (int vt = 0; vt < 8; ++vt) { O[vt][0] = O[vt][1] = (f32x4){0.f, 0.f, 0.f, 0.f}; }
        L[0] = L[1] = (f32x4){0.f, 0.f, 0.f, 0.f};
        const bf16_t* gKm = MKN + (size_t)(b * 256 + (tid >> 4)) * 512 + hc * 128 + (tid & 15) * 8;
        const bf16_t* gVm = VTC + ((size_t)((b * 4 + hc) * 256 + vhalf * 128 + (tid >> 3))) * 256 + (tid & 7) * 8;
        v4u rk[4], rv[4];
#pragma unroll
        for (int i = 0; i < 4; ++i) { rk[i] = *(const v4u*)(gKm + (size_t)(16 * i) * 512); rv[i] = *(const v4u*)(gVm + (size_t)(32 * i) * 256); }
#pragma unroll 1
        for (int kt = 0; kt < 4; ++kt) {
            __syncthreads();
#pragma unroll
            for (int i = 0; i < 4; ++i) {
                *(v4u*)(sK + ((tid >> 4) + 16 * i) * 136 + (tid & 15) * 8) = rk[i];
                *(v4u*)(sVt + ((tid >> 3) + 32 * i) * 72 + (tid & 7) * 8) = rv[i];
            }
            __syncthreads();
            {
                const int kn = kt < 3 ? kt + 1 : 3;
#pragma unroll
                for (int i = 0; i < 4; ++i) { rk[i] = *(const v4u*)(gKm + (size_t)(kn * 64 + 16 * i) * 512); rv[i] = *(const v4u*)(gVm + (size_t)(32 * i) * 256 + kn * 64); }
            }
            __builtin_amdgcn_sched_barrier(0);
#pragma unroll
            for (int kp = 0; kp < 2; ++kp) {
                f32x4 s[2][2];
                qk_tile<128>(s, sQ + (32 * w) * 136, sK + (kp * 32) * 136, 0, r16, q, init);
                bf16x8 pf[2];
                make_p<false>(pf, s, 0, 0);
                L[0] = MFMA(ones, pf[0], L[0]); L[1] = MFMA(ones, pf[1], L[1]);
#pragma unroll
                for (int vt = 0; vt < 8; ++vt) {
                    const bf16x8 vf = load_vfrag(sVt, vt, kp, r16, q);
                    O[vt][0] = MFMA(vf, pf[0], O[vt][0]); O[vt][1] = MFMA(vf, pf[1], O[vt][1]);
                }
            }
        }
#pragma unroll
        for (int jt = 0; jt < 2; ++jt) {
            const float r1 = 1.0f / L[jt][0];
#pragma unroll
            for (int vt = 0; vt < 8; ++vt) {
                const int v0 = vhalf * 128 + vt * 16 + 4 * q;
                uint2 ov; ov.x = cvt_pk_bf16(O[vt][jt][0] * r1, O[vt][jt][1] * r1); ov.y = cvt_pk_bf16(O[vt][jt][2] * r1, O[vt][jt][3] * r1);
                *(uint2*)(PROJ + (size_t)(tq0 + 32 * w + 16 * jt + r16) * LDP + C_DK + hc * 256 + v0) = ov;
            }
        }
    }
}

__device__ void phase5(const Params& p, unsigned char* smem) {
    unsigned char* ws = p.ws;
    const int tid = opaque_tid(), lane = tid & 63, w = tid >> 6, r16 = lane & 15, q = lane >> 4, wa = w & 1, wb = w >> 1;
    bf16_t* PROJ = (bf16_t*)(ws + OFF_PROJ);
    const bf16_t* H = (const bf16_t*)((unsigned char*)p.out + OUT_H);
    const float* bg = p.in[21];
    for (int tile = blockIdx.x; tile < 256 * 8; tile += gridDim.x) {
        int mt, nt; map_tile(tile, 8, mt, nt);
        const int m0 = mt * 128, n0 = nt * 128;
#pragma unroll 1
        for (int br = 0; br < 3; ++br) {
            const int ycol = br == 0 ? C_MO : (br == 1 ? C_DQ : C_DK);
            const size_t woff = br == 0 ? OFF_WPM : (br == 1 ? OFF_WPD : OFF_WPC);
            unsigned gpk[4][4][2];
            f32x4 acc[4][4];
            zero_acc<4>(acc);
            gemm_acc<128, false>(acc, H + (size_t)m0 * 1024, 1024, (const bf16_t*)(ws + OFF_WG) + (size_t)(br * 1024 + n0) * 1024, 1024, 1024, smem);
            const int t1 = opaque_tid(), q1 = (t1 & 63) >> 4, wa1 = (t1 >> 6) & 1;
#pragma unroll
            for (int i = 0; i < 4; ++i) {
                const int n = n0 + wa1 * 64 + i * 16 + nq_of(q1);
                const float4 bb = *(const float4*)(bg + br * 1024 + n);
#pragma unroll
                for (int j = 0; j < 4; ++j) {
                    gpk[i][j][0] = pack2(sigmoidf_(acc[i][j][0] + bb.x), sigmoidf_(acc[i][j][1] + bb.y));
                    gpk[i][j][1] = pack2(sigmoidf_(acc[i][j][2] + bb.z), sigmoidf_(acc[i][j][3] + bb.w));
                }
            }
            zero_acc<4>(acc);
            gemm_acc<128, false>(acc, PROJ + (size_t)m0 * LDP + ycol, LDP, (const bf16_t*)(ws + woff) + (size_t)n0 * 1024, 1024, 1024, smem);
            const int t2 = opaque_tid(), l2 = t2 & 63, w2 = t2 >> 6, r2 = l2 & 15, q2 = l2 >> 4, wa2 = w2 & 1, wb2 = w2 >> 1;
#pragma unroll
            for (int i = 0; i < 4; i += 2)
#pragma unroll
                for (int j = 0; j < 4; ++j) {
                    const int n = n0 + wa2 * 64 + (i + (q2 >> 1)) * 16 + 8 * (q2 & 1), m = m0 + wb2 * 64 + j * 16 + r2;
                    v4u* mp = (v4u*)(PROJ + (size_t)m * LDP + C_DV + n);
                    float mv[2][4];
#pragma unroll
                    for (int e = 0; e < 2; ++e) {
                        mv[e][0] = __uint_as_float(gpk[i + e][j][0] << 16) * acc[i + e][j][0]; mv[e][1] = __uint_as_float(gpk[i + e][j][0] & 0xffff0000u) * acc[i + e][j][1];
                        mv[e][2] = __uint_as_float(gpk[i + e][j][1] << 16) * acc[i + e][j][2]; mv[e][3] = __uint_as_float(gpk[i + e][j][1] & 0xffff0000u) * acc[i + e][j][3];
                    }
                    if (br > 0) {
                        const v4u pv = *mp;
                        unsigned ax = pv.x, ay = pv.y, bx = pv.z, by = pv.w;
                        { auto r_ = __builtin_amdgcn_permlane32_swap(ax, bx, false, false); ax = r_[0]; bx = r_[1]; }
                        { auto r_ = __builtin_amdgcn_permlane32_swap(ay, by, false, false); ay = r_[0]; by = r_[1]; }
                        mv[0][0] += __uint_as_float(ax << 16); mv[0][1] += __uint_as_float(ax & 0xffff0000u); mv[0][2] += __uint_as_float(ay << 16); mv[0][3] += __uint_as_float(ay & 0xffff0000u);
                        mv[1][0] += __uint_as_float(bx << 16); mv[1][1] += __uint_as_float(bx & 0xffff0000u); mv[1][2] += __uint_as_float(by << 16); mv[1][3] += __uint_as_float(by & 0xffff0000u);
                    }
                    unsigned ax = pack2(mv[0][0], mv[0][1]), ay = pack2(mv[0][2], mv[0][3]), bx = pack2(mv[1][0], mv[1][1]), by = pack2(mv[1][2], mv[1][3]);
                    { auto r_ = __builtin_amdgcn_permlane32_swap(ax, bx, false, false); ax = r_[0]; bx = r_[1]; }
                    { auto r_ = __builtin_amdgcn_permlane32_swap(ay, by, false, false); ay = r_[0]; by = r_[1]; }
                    v4u o; o.x = ax; o.y = ay; o.z = bx; o.w = by;
                    *mp = o;
                }
        }
    }
}

__device__ void phase6(const Params& p, unsigned char* smem) {
    unsigned char* ws = p.ws;
    bf16_t* PROJ = (bf16_t*)(ws + OFF_PROJ);
    bf16_t* X1B = (bf16_t*)((unsigned char*)p.out + OUT_H);
    float* SSQ = (float*)(ws + OFF_SSQ);
    const float* x = p.in[0];
    for (int tile = blockIdx.x; tile < 256 * 8; tile += gridDim.x) {
        int mt, nt; map_tile(tile, 8, mt, nt);
        const int m0 = mt * 128, n0 = nt * 128;
        f32x4 acc[4][4]; zero_acc<4>(acc);
        gemm_acc<128, false>(acc, PROJ + (size_t)m0 * LDP + C_DV, LDP, (const bf16_t*)(ws + OFF_WOUT) + (size_t)n0 * 1024, 1024, 1024, smem);
        const int tid = opaque_tid(), lane = tid & 63, w = tid >> 6, r16 = lane & 15, q = lane >> 4, wa = w & 1, wb = w >> 1;
#pragma unroll
        for (int j = 0; j < 4; ++j) {
            const int m = m0 + wb * 64 + j * 16 + r16;
#pragma unroll
            for (int i = 0; i < 4; ++i) {
                const int n = n0 + wa * 64 + i * 16 + nq_of(q);
                const float4 xv = *(const float4*)(x + (size_t)m * 1024 + n);
                float4 o; o.x = xv.x + acc[i][j][0]; o.y = xv.y + acc[i][j][1]; o.z = xv.z + acc[i][j][2]; o.w = xv.w + acc[i][j][3];
                *(float4*)((float*)(PROJ + (size_t)m * LDP) + n) = o;
            }
        }
    }
}


__device__ void phase6b(const Params& p) {
    unsigned char* ws = p.ws;
    const int tid = opaque_tid(), lane = tid & 63, w = tid >> 6;
    const bf16_t* PROJ = (const bf16_t*)(ws + OFF_PROJ);
    bf16_t* X1B = (bf16_t*)((unsigned char*)p.out + OUT_H);
    float* SSQ = (float*)(ws + OFF_SSQ);
    const int rstride = gridDim.x * 4;
    float4 vn[4], vn2[4];
    {
        const int row = blockIdx.x * 4 + w, row2 = (row + rstride < T_TOK) ? row + rstride : row;
        const float* src = (const float*)(PROJ + (size_t)row * LDP); const float* src2 = (const float*)(PROJ + (size_t)row2 * LDP);
#pragma unroll
        for (int i = 0; i < 4; ++i) { vn[i] = *(const float4*)(src + lane * 4 + 256 * i); vn2[i] = *(const float4*)(src2 + lane * 4 + 256 * i); }
    }
    for (int row = blockIdx.x * 4 + w; row < T_TOK; row += rstride) {
        float4 v[4]; float ss = 0.f;
#pragma unroll
        for (int i = 0; i < 4; ++i) { v[i] = vn[i]; vn[i] = vn2[i]; ss += v[i].x * v[i].x + v[i].y * v[i].y + v[i].z * v[i].z + v[i].w * v[i].w; }
        {
            const int rn = (row + 2 * rstride < T_TOK) ? row + 2 * rstride : row;
            const float* srcn = (const float*)(PROJ + (size_t)rn * LDP);
#pragma unroll
            for (int i = 0; i < 4; ++i) vn2[i] = *(const float4*)(srcn + lane * 4 + 256 * i);
        }
        ss = wave_sum(ss);
        if (lane == 0) SSQ[row] = ss;
#pragma unroll
        for (int i = 0; i < 4; ++i) {
            uint2 o; o.x = pack2(v[i].x, v[i].y); o.y = pack2(v[i].z, v[i].w);
            *(uint2*)(X1B + (size_t)row * 1024 + lane * 4 + 256 * i) = o;
        }
    }
}


__device__ void phase7(const Params& p, unsigned char* smem) {
    unsigned char* ws = p.ws;
    bf16_t* PROJ = (bf16_t*)(ws + OFF_PROJ);
    const bf16_t* H2 = (const bf16_t*)((unsigned char*)p.out + OUT_H);
    const float* SSQ = (const float*)(ws + OFF_SSQ);
    for (int tile = blockIdx.x; tile < 256 * 16; tile += gridDim.x) {
        int mt, nt; map_tile(tile, 16, mt, nt);
        const int m0 = mt * 128, n0 = nt * 256;
        f32x4 acc[8][4];
#pragma unroll
        for (int i = 0; i < 8; ++i)
#pragma unroll
            for (int j = 0; j < 4; ++j) acc[i][j] = (f32x4){0.f, 0.f, 0.f, 0.f};
        gemm_wide(acc, H2 + (size_t)m0 * 1024, 1024, (const bf16_t*)(ws + OFF_WUP) + (size_t)n0 * 1024, 1024, 1024, smem);
        const int tid = opaque_tid(), lane = tid & 63, w = tid >> 6, r16 = lane & 15, q = lane >> 4, wa = w & 1, wb = w >> 1;
#pragma unroll
        for (int j = 0; j < 4; ++j) {
            const int m = m0 + wb * 64 + j * 16 + r16;
            const float r2 = 1.0f / (SSQ[m] * (1.0f / 1024.0f) + EPS);
#pragma unroll
            for (int i = 0; i < 8; i += 2) {
                const int n = n0 + wa * 128 + (i + (q >> 1)) * 16 + 8 * (q & 1);
                unsigned pk[2][2];
#pragma unroll
                for (int e = 0; e < 2; ++e) {
                    const float a0 = fmaxf(acc[i + e][j][0], 0.f), a1 = fmaxf(acc[i + e][j][1], 0.f), a2 = fmaxf(acc[i + e][j][2], 0.f), a3 = fmaxf(acc[i + e][j][3], 0.f);
                    pk[e][0] = pack2(a0 * a0 * r2, a1 * a1 * r2); pk[e][1] = pack2(a2 * a2 * r2, a3 * a3 * r2);
                }
                { auto r_ = __builtin_amdgcn_permlane32_swap(pk[0][0], pk[1][0], false, false); pk[0][0] = r_[0]; pk[1][0] = r_[1]; }
                { auto r_ = __builtin_amdgcn_permlane32_swap(pk[0][1], pk[1][1], false, false); pk[0][1] = r_[0]; pk[1][1] = r_[1]; }
                v4u o; o.x = pk[0][0]; o.y = pk[0][1]; o.z = pk[1][0]; o.w = pk[1][1];
                *(v4u*)(PROJ + (size_t)m * LDP + 2048 + n) = o;
            }
        }
    }
}

__device__ void phase8(const Params& p, unsigned char* smem) {
    unsigned char* ws = p.ws;
    const bf16_t* PROJ = (const bf16_t*)(ws + OFF_PROJ);
    for (int tile = blockIdx.x; tile < 256 * 4; tile += gridDim.x) {
        int mt, nt; map_tile(tile, 4, mt, nt);
        const int m0 = mt * 128, n0 = nt * 256;
        f32x4 acc[8][4];
#pragma unroll
        for (int i = 0; i < 8; ++i)
#pragma unroll
            for (int j = 0; j < 4; ++j) acc[i][j] = (f32x4){0.f, 0.f, 0.f, 0.f};
        gemm_wide(acc, PROJ + (size_t)m0 * LDP + 2048, LDP, (const bf16_t*)(ws + OFF_WDN) + (size_t)n0 * 4096, 4096, 4096, smem);
        const int tid = opaque_tid(), lane = tid & 63, w = tid >> 6, r16 = lane & 15, q = lane >> 4, wa = w & 1, wb = w >> 1;
#pragma unroll
        for (int j = 0; j < 4; ++j) {
            const int m = m0 + wb * 64 + j * 16 + r16;
#pragma unroll
            for (int i = 0; i < 8; ++i) {
                const int n = n0 + wa * 128 + i * 16 + nq_of(q);
                const float4 xv = *(const float4*)((const float*)(PROJ + (size_t)m * LDP) + n);
                float4 o; o.x = xv.x + acc[i][j][0]; o.y = xv.y + acc[i][j][1]; o.z = xv.z + acc[i][j][2]; o.w = xv.w + acc[i][j][3];
                *(float4*)(p.out + (size_t)m * 1024 + n) = o;
            }
        }
    }
}


constexpr int N_PHASES = 13;
__global__ void __launch_bounds__(256, 2) fwd_megakernel(Params p) {
    __shared__ __attribute__((aligned(16))) unsigned char smem[73728];
    __shared__ int s_task;
    const int ph_lo = (int)(p.ph_lo_hi & 0xffffffffll), ph_hi = (int)(p.ph_lo_hi >> 32);
    __shared__ uint4 xb_words;
    unsigned* xbar = (unsigned*)(p.ws + OFF_XBAR);
    if (threadIdx.x == 0) { xb_words = make_uint4(0u, 0u, 0u, 0u); (void)xb_add(&xbar[XB_XCNT(xb_xcc_id())], 1u); }
    __syncthreads();
    if (p.ph_lo_hi == -1) cg::this_grid().sync();
#ifndef PROBE_DOUBLE
#define PROBE_DOUBLE 0
#endif
#define RUN_PHASE(N, CALL) if (ph_lo <= (N) && (N) < ph_hi) { CALL; if ((N) + 1 < ph_hi) xcd_barrier(xbar, (volatile LAS unsigned*)&xb_words); }
    RUN_PHASE(0, phase0(p, smem))
    RUN_PHASE(1, phase1(p, smem))
    RUN_PHASE(2, phase2a(p, smem))
    RUN_PHASE(3, phase2b(p, smem))
    RUN_PHASE(4, phase2c(p))
    RUN_PHASE(5, phase2d(p, smem))
    RUN_PHASE(6, phase3(p, smem, &s_task))
    RUN_PHASE(7, phase4(p, smem))
    RUN_PHASE(8, phase5(p, smem))
    RUN_PHASE(9, phase6(p, smem))
    RUN_PHASE(10, phase6b(p))
    RUN_PHASE(11, phase7(p, smem))
    RUN_PHASE(12, phase8(p, smem))
}

extern "C" void kernel_launch(void* const* d_in, const int* in_sizes, int n_in, void* d_out, int out_size, void* d_ws, size_t ws_size, hipStream_t stream) {
    static int grid_blocks = 0;
    if (!grid_blocks) {
        if (n_in != 29 || out_size != T_TOK * DM || ws_size < WS_END) {
            fprintf(stderr, "kernel_launch: unexpected shapes n_in %d out %d ws %zu (need %zu)\n", n_in, out_size, ws_size, (size_t)WS_END);
            grid_blocks = -1; return;
        }
        int dev = 0, cus = 0, per_cu = 0;
        hipGetDevice(&dev);
        hipDeviceGetAttribute(&cus, hipDeviceAttributeMultiprocessorCount, dev);
        hipOccupancyMaxActiveBlocksPerMultiprocessor(&per_cu, fwd_megakernel, 256, 0);
        if (per_cu < 1) per_cu = 1;
        if (per_cu > 2) per_cu = 2;
        grid_blocks = cus * per_cu;
        grid_blocks &= ~7;
        fprintf(stderr, "kernel_launch: cus %d per_cu %d grid %d ws %zu need %zu\n", cus, per_cu, grid_blocks, ws_size, (size_t)WS_END);
    }
    if (grid_blocks < 0) return;
    hipMemsetAsync((unsigned char*)d_ws + OFF_CTR, 0, 256 + 16384, stream);
    Params p{};
    for (int i = 0; i < 29; ++i) p.in[i] = (const float*)d_in[i];
    p.out = (float*)d_out; p.ws = (unsigned char*)d_ws;
#if MULTI_LAUNCH
    for (int ph = 0; ph < N_PHASES; ++ph) {
        p.ph_lo_hi = (long long)ph | ((long long)(ph + 1) << 32);
        hipLaunchKernelGGL(fwd_megakernel, dim3(grid_blocks), dim3(256), 0, stream, p);
    }
#else
    p.ph_lo_hi = 0ll | ((long long)N_PHASES << 32);
    void* args[] = {&p};
    hipError_t e = hipLaunchCooperativeKernel((const void*)fwd_megakernel, dim3(grid_blocks), dim3(256), args, 0, stream);
    if (e != hipSuccess) fprintf(stderr, "cooperative launch failed: %s (grid %d)\n", hipGetErrorString(e), grid_blocks);
#endif
}
```

```cpp
#include <hip/hip_runtime.h>
#include <hip/hip_cooperative_groups.h>
#include <cstdio>
#include <cstdint>
namespace cg = cooperative_groups;

#ifndef MULTI_LAUNCH
#define MULTI_LAUNCH 0
#endif

typedef unsigned short bf16_t;
typedef short bf16x8 __attribute__((ext_vector_type(8)));
typedef float f32x4 __attribute__((ext_vector_type(4)));
#define MFMA(a, b, c) __builtin_amdgcn_mfma_f32_16x16x32_bf16((a), (b), (c), 0, 0, 0)

constexpr int T_TOK = 32768, DM = 1024, SEQ = 8192, NB = 4;
constexpr int LDP = 6656;
constexpr int C_MQ = 0, C_MK = 512, C_MV = 1024, C_MO = 2048, C_DQ = 3072, C_DK = 4096, C_DV = 5120, C_CQ = 6144;
constexpr float EPS = 1e-6f;

constexpr size_t OFF_PROJ = 0;
constexpr size_t OFF_W1   = OFF_PROJ + (size_t)T_TOK * LDP * 2;
constexpr size_t OFF_WG   = OFF_W1 + (size_t)6656 * 1024 * 2;
constexpr size_t OFF_WPM  = OFF_WG + (size_t)3072 * 1024 * 2;
constexpr size_t OFF_WPD  = OFF_WPM + (size_t)1024 * 1024 * 2;
constexpr size_t OFF_WPC  = OFF_WPD + (size_t)1024 * 1024 * 2;
constexpr size_t OFF_WOUT = OFF_WPC + (size_t)1024 * 1024 * 2;
constexpr size_t OFF_WUP  = OFF_WOUT + (size_t)1024 * 1024 * 2;
constexpr size_t OFF_WDN  = OFF_WUP + (size_t)4096 * 1024 * 2;
constexpr size_t OFF_WMKV = OFF_WDN + (size_t)4096 * 1024 * 2;
constexpr size_t OFF_HMEM = OFF_WMKV + (size_t)1536 * 1024 * 2;
constexpr size_t OFF_MKN  = OFF_HMEM + (size_t)1024 * 1024 * 2;
constexpr size_t OFF_VTC  = OFF_MKN + (size_t)1024 * 512 * 2;
constexpr size_t OFF_IG   = OFF_VTC + (size_t)16 * 256 * 256 * 2;
constexpr size_t OFF_LF   = OFF_IG + (size_t)T_TOK * 4 * 4;
constexpr size_t OFF_BCUM = OFF_LF + (size_t)T_TOK * 4 * 4;
constexpr size_t OFF_MPREV = OFF_BCUM + (size_t)T_TOK * 4 * 4;
constexpr size_t OFF_MNEW = OFF_MPREV + 4096;
constexpr size_t OFF_NST  = OFF_MNEW + 4096;
constexpr size_t OFF_CTR  = OFF_NST + (size_t)1024 * 128 * 4;
constexpr size_t OFF_XBAR = OFF_CTR + 256;
constexpr size_t OFF_SSQ  = OFF_XBAR + 16384;
constexpr size_t WS_END   = OFF_SSQ + (size_t)T_TOK * 4;
constexpr size_t OUT_H = 0, OUT_TMP = (size_t)T_TOK * 1024 * 2;

struct Params {
    const float* in[29];
    float* out;
    unsigned char* ws;
    long long ph_lo_hi;
};

typedef __bf16 bf2_t __attribute__((ext_vector_type(2)));
typedef float f2_t __attribute__((ext_vector_type(2)));
__device__ __forceinline__ bf16_t f2bf(float f) { return __builtin_bit_cast(bf16_t, (__bf16)f); }
__device__ __forceinline__ float bf2f(bf16_t b) { return __uint_as_float(((unsigned)b) << 16); }
__device__ __forceinline__ unsigned pack2(float a, float b) { f2_t f = {a, b}; bf2_t v = __builtin_convertvector(f, bf2_t); return __builtin_bit_cast(unsigned, v); }
__device__ __forceinline__ void unpack8(const uint4& v, float* f) {
    f[0] = __uint_as_float(v.x << 16); f[1] = __uint_as_float(v.x & 0xffff0000u);
    f[2] = __uint_as_float(v.y << 16); f[3] = __uint_as_float(v.y & 0xffff0000u);
    f[4] = __uint_as_float(v.z << 16); f[5] = __uint_as_float(v.z & 0xffff0000u);
    f[6] = __uint_as_float(v.w << 16); f[7] = __uint_as_float(v.w & 0xffff0000u);
}
__device__ __forceinline__ uint4 pack8(const float* f) { uint4 v; v.x = pack2(f[0], f[1]); v.y = pack2(f[2], f[3]); v.z = pack2(f[4], f[5]); v.w = pack2(f[6], f[7]); return v; }
__device__ __forceinline__ float sigmoidf_(float x) { return 1.0f / (1.0f + __expf(-x)); }
__device__ __forceinline__ float wave_sum(float v) { for (int m = 32; m >= 1; m >>= 1) v += __shfl_xor(v, m); return v; }
__device__ __forceinline__ float wave_max(float v) { for (int m = 32; m >= 1; m >>= 1) v = fmaxf(v, __shfl_xor(v, m)); return v; }

__device__ __forceinline__ int opaque_tid() { int t = threadIdx.x; asm volatile("" : "+v"(t)); return t; }

__device__ __forceinline__ int perm16(int r) { return (r & 3) | ((r & 4) << 1) | ((r & 8) >> 1); }
__device__ __forceinline__ int nq_of(int q) { return ((q & 1) << 3) | ((q >> 1) << 2); }


#define XB_TMO      128
#define XB_XCNT(j)  (256  + 64 * (j))
#define XB_XSUB(j)  (1280 + 64 * (j))
#define XB_XGEN(j)  (2304 + 64 * (j))
#define XB_TOP      3328
#define XB_TOPGEN   3392
#define XCD_BAR_WORDS 3456
#define XB_SPIN_CAP (1u << 20)
#define LAS __attribute__((address_space(3)))
__device__ __forceinline__ unsigned xb_ld(unsigned* p)              { return __hip_atomic_load(p, __ATOMIC_RELAXED, __HIP_MEMORY_SCOPE_AGENT); }
__device__ __forceinline__ unsigned xb_add(unsigned* p, unsigned v) { return __hip_atomic_fetch_add(p, v, __ATOMIC_RELAXED, __HIP_MEMORY_SCOPE_AGENT); }
__device__ __forceinline__ unsigned xb_xcc_id() { return (unsigned)__builtin_amdgcn_s_getreg((3 << 11) | 20) & 0xFu; }
#define XB_SPIN(cond, bar) do { unsigned _sp = 0; while (cond) { __builtin_amdgcn_s_sleep(1); \
    if ((++_sp & 255u) == 0u) { if (xb_ld(&(bar)[XB_TMO])) break; if (_sp > XB_SPIN_CAP) { atomicAdd(&(bar)[XB_TMO], 1u); break; } } } } while (0)
__device__ __forceinline__ void xcd_barrier_complete(unsigned* bar, unsigned x, unsigned& nloc, unsigned& nx) {
    const unsigned G = gridDim.x * gridDim.y * gridDim.z;
    unsigned sum, cnt, mine, sp = 0u;
    for (;;) {
        sum = 0u; cnt = 0u; mine = 0u;
#pragma unroll
        for (unsigned j = 0; j < 16; ++j) { const unsigned c = xb_ld(&bar[XB_XCNT(j)]); sum += c; cnt += (c > 0u) ? 1u : 0u; mine = (j == x) ? c : mine; }
        if (sum == G) break;
        __builtin_amdgcn_s_sleep(1);
        if ((++sp & 255u) == 0u) { if (xb_ld(&bar[XB_TMO])) break; if (sp > XB_SPIN_CAP) { atomicAdd(&bar[XB_TMO], 1u); break; } }
    }
    nloc = mine > 0u ? mine : 1u; nx = cnt > 0u ? cnt : 1u;
}
__device__ __forceinline__ void xcd_barrier(unsigned* bar, volatile LAS unsigned* st) {
    asm volatile("s_waitcnt vmcnt(0)" ::: "memory");
    __syncthreads();
    if (threadIdx.x == 0) {
        const unsigned x = xb_xcc_id();
        __builtin_amdgcn_s_waitcnt(0);
        unsigned nloc = st[0], nx = st[1];
        if (nloc == 0u) { xcd_barrier_complete(bar, x, nloc, nx); st[0] = nloc; st[1] = nx; }
        const unsigned old = xb_add(&bar[XB_XSUB(x)], 1u);
        const unsigned gen = old / nloc;
        if (old + 1u == (gen + 1u) * nloc) {
            __builtin_amdgcn_fence(__ATOMIC_RELEASE, "agent");
            asm volatile("s_waitcnt vmcnt(0)" ::: "memory");
            const unsigned og = xb_add(&bar[XB_TOP], 1u);
            const unsigned tg = og / nx;
            if (og + 1u == (tg + 1u) * nx) xb_add(&bar[XB_TOPGEN], 1u);
            else XB_SPIN(xb_ld(&bar[XB_TOPGEN]) == tg, bar);
            __builtin_amdgcn_fence(__ATOMIC_ACQUIRE, "agent");
            xb_add(&bar[XB_XGEN(x)], 1u);
            asm volatile("s_waitcnt vmcnt(0)" ::: "memory");
        } else {
            XB_SPIN(xb_ld(&bar[XB_XGEN(x)]) == gen, bar);
            __builtin_amdgcn_fence(__ATOMIC_ACQUIRE, "agent");
            asm volatile("s_waitcnt vmcnt(0)" ::: "memory");
        }
    }
    __syncthreads();
}

__device__ __forceinline__ void map_tile(int tile, int NT, int& mt, int& nt) {
    const int xcd = tile & 7, j = tile >> 3, ml = j & 7, jj = j >> 3;
    nt = jj % NT; const int mg = jj / NT; mt = xcd * 32 + mg * 8 + ml;
}

typedef unsigned v4u __attribute__((ext_vector_type(4)));
template <int NB_>
__device__ __forceinline__ void g_load(v4u (&ra)[4], v4u (&rb)[NB_], const bf16_t* gA, int lda, const bf16_t* gB, int ldb, int kt) {
    const int k0 = kt << 6;
#pragma unroll
    for (int i = 0; i < 4; ++i) ra[i] = *(const v4u*)(gA + (size_t)(i * 32) * lda + k0);
#pragma unroll
    for (int i = 0; i < NB_; ++i) rb[i] = *(const v4u*)(gB + (size_t)(i * 32) * ldb + k0);
}
template <int NB_>
__device__ __forceinline__ void s_store(const v4u (&ra)[4], const v4u (&rb)[NB_], bf16_t* dA, bf16_t* dB) {
#pragma unroll
    for (int i = 0; i < 4; ++i) *(v4u*)(dA + i * 32 * 64) = ra[i];
#pragma unroll
    for (int i = 0; i < NB_; ++i) *(v4u*)(dB + i * 32 * 64) = rb[i];
}
template <int NIA>
__device__ __forceinline__ void mma_step(f32x4 (&acc)[NIA][4], const bf16_t* pa, const bf16_t* pb, int c0a, int c0b) {
#pragma unroll
    for (int ks = 0; ks < 2; ++ks) {
        const int coa = c0a ^ (ks * 32), cob = c0b ^ (ks * 32);
        bf16x8 af[NIA], bfr[4];
#pragma unroll
        for (int i = 0; i < NIA; ++i) af[i] = *(const bf16x8*)(pa + i * 16 * 64 + coa);
#pragma unroll
        for (int j = 0; j < 4; ++j) bfr[j] = *(const bf16x8*)(pb + j * 16 * 64 + cob);
#pragma unroll
        for (int i = 0; i < NIA; ++i)
#pragma unroll
            for (int j = 0; j < 4; ++j) acc[i][j] = MFMA(af[i], bfr[j], acc[i][j]);
    }
}
template <int BN, bool SWAP>
__device__ __forceinline__ void gemm_acc(f32x4 (&acc)[BN / 32][4], const bf16_t* __restrict__ A, int lda, const bf16_t* __restrict__ Bt, int ldb,
                                         int K, unsigned char* smem) {
    constexpr int NB_ = BN / 32;
    constexpr int SA = 128 * 64, SB = BN * 64;
    bf16_t* sA = (bf16_t*)smem;
    bf16_t* sB = sA + 2 * SA;
    const int tid = opaque_tid(), lane = tid & 63, w = tid >> 6, r16 = lane & 15, q = lane >> 4;
    const int wa = w & 1, wb = w >> 1;
    const int nk = K >> 6;
    const bf16_t* gA = A + (size_t)(tid >> 3) * lda + (tid & 7) * 8;
    const bf16_t* gB = Bt + (size_t)(tid >> 3) * ldb + (tid & 7) * 8;
    const int soff = (tid >> 3) * 64 + (((tid & 7) ^ ((tid >> 4) & 7)) << 3);
    const int ra_ = SWAP ? r16 : perm16(r16);
    const int c0a = ((q ^ (ra_ >> 1)) & 7) << 3, c0b = ((q ^ (r16 >> 1)) & 7) << 3;
    const bf16_t* pa0; const bf16_t* pb0; int sta, stb;
    if (!SWAP) { pa0 = sB + (wa * (BN / 2)) * 64 + ra_ * 64; pb0 = sA + (wb * 64) * 64 + r16 * 64; sta = SB; stb = SA; }
    else       { pa0 = sA + (wa * 64) * 64 + ra_ * 64;       pb0 = sB + (wb * 64) * 64 + r16 * 64; sta = SA; stb = SB; }
    v4u ra0[4], rb0[NB_], ra1[4], rb1[NB_];
    g_load<NB_>(ra0, rb0, gA, lda, gB, ldb, 0);
    g_load<NB_>(ra1, rb1, gA, lda, gB, ldb, 1);
    s_store<NB_>(ra0, rb0, sA + soff, sB + soff);
    __syncthreads();
#pragma unroll 1
    for (int kt = 0; kt < nk - 2; kt += 2) {
        g_load<NB_>(ra0, rb0, gA, lda, gB, ldb, kt + 2);
        __builtin_amdgcn_sched_barrier(0);
        __builtin_amdgcn_s_setprio(1);
        mma_step<BN / 32>(acc, pa0, pb0, c0a, c0b);
        s_store<NB_>(ra1, rb1, sA + SA + soff, sB + SB + soff);
        __builtin_amdgcn_s_setprio(0);
        __syncthreads();
        g_load<NB_>(ra1, rb1, gA, lda, gB, ldb, kt + 3);
        __builtin_amdgcn_sched_barrier(0);
        __builtin_amdgcn_s_setprio(1);
        mma_step<BN / 32>(acc, pa0 + sta, pb0 + stb, c0a, c0b);
        s_store<NB_>(ra0, rb0, sA + soff, sB + soff);
        __builtin_amdgcn_s_setprio(0);
        __syncthreads();
    }
    mma_step<BN / 32>(acc, pa0, pb0, c0a, c0b);
    s_store<NB_>(ra1, rb1, sA + SA + soff, sB + SB + soff);
    __syncthreads();
    mma_step<BN / 32>(acc, pa0 + sta, pb0 + stb, c0a, c0b);
    __syncthreads();
}

template <int BN>
__device__ __forceinline__ void gemm_acc_lite(f32x4 (&acc)[BN / 32][4], const bf16_t* __restrict__ A, int lda, const bf16_t* __restrict__ Bt, int ldb,
                                              int K, unsigned char* smem) {
    constexpr int NB_ = BN / 32;
    constexpr int SA = 128 * 64, SB = BN * 64;
    bf16_t* sA = (bf16_t*)smem; bf16_t* sB = sA + 2 * SA;
    const int tid = opaque_tid(), lane = tid & 63, w = tid >> 6, r16 = lane & 15, q = lane >> 4;
    const int wa = w & 1, wb = w >> 1;
    const int nk = K >> 6;
    const bf16_t* gA = A + (size_t)(tid >> 3) * lda + (tid & 7) * 8;
    const bf16_t* gB = Bt + (size_t)(tid >> 3) * ldb + (tid & 7) * 8;
    const int soff = (tid >> 3) * 64 + (((tid & 7) ^ ((tid >> 4) & 7)) << 3);
    const int c0 = ((q ^ (r16 >> 1)) & 7) << 3;
    const bf16_t* pa0 = sB + (wa * (BN / 2)) * 64 + r16 * 64;
    const bf16_t* pb0 = sA + (wb * 64) * 64 + r16 * 64;
    v4u ra[4], rb[NB_];
    g_load<NB_>(ra, rb, gA, lda, gB, ldb, 0);
    s_store<NB_>(ra, rb, sA + soff, sB + soff);
    __syncthreads();
#pragma unroll 1
    for (int kt = 0; kt < nk - 2; kt += 2) {
        g_load<NB_>(ra, rb, gA, lda, gB, ldb, kt + 1);
        __builtin_amdgcn_sched_barrier(0);
        mma_step<BN / 32>(acc, pa0, pb0, c0);
        s_store<NB_>(ra, rb, sA + SA + soff, sB + SB + soff);
        __syncthreads();
        g_load<NB_>(ra, rb, gA, lda, gB, ldb, kt + 2);
        __builtin_amdgcn_sched_barrier(0);
        mma_step<BN / 32>(acc, pa0 + SB, pb0 + SA, c0);
        s_store<NB_>(ra, rb, sA + soff, sB + soff);
        __syncthreads();
    }
    g_load<NB_>(ra, rb, gA, lda, gB, ldb, nk - 1);
    __builtin_amdgcn_sched_barrier(0);
    mma_step<BN / 32>(acc, pa0, pb0, c0);
    s_store<NB_>(ra, rb, sA + SA + soff, sB + SB + soff);
    __syncthreads();
    mma_step<BN / 32>(acc, pa0 + SB, pb0 + SA, c0);
    __syncthreads();
}

__device__ __forceinline__ int swz32(int r) { return (0x78 >> (2 * ((r >> 2) & 3))) & 3; }
__device__ __forceinline__ void gemm_wide(f32x4 (&acc)[8][4], const bf16_t* __restrict__ A, int lda, const bf16_t* __restrict__ Bt, int ldb,
                                          int K, unsigned char* smem) {
    constexpr int SA = 128 * 32, SB = 256 * 32;
    bf16_t* sA = (bf16_t*)smem;
    bf16_t* sB = sA + 2 * SA;
    const int tid = opaque_tid(), lane = tid & 63, w = tid >> 6, r16 = lane & 15, q = lane >> 4;
    const int wa = w & 1, wb = w >> 1;
    const int nk = K >> 5;
    const int lrow = tid >> 2, lc = tid & 3;
    const bf16_t* gA = A + (size_t)lrow * lda + lc * 8;
    const bf16_t* gB = Bt + (size_t)lrow * ldb + lc * 8;
    const int soff = lrow * 32 + ((lc ^ swz32(lrow)) << 3);
    const int foff = r16 * 32 + ((q ^ swz32(r16)) << 3);
    const int pr_ = perm16(r16), foffp = pr_ * 32 + ((q ^ swz32(pr_)) << 3);
    const bf16_t* pa0 = sB + (wa * 128) * 32 + foffp;
    const bf16_t* pb0 = sA + (wb * 64) * 32 + foff;
    v4u ra[2], rb[4];
#pragma unroll
    for (int i = 0; i < 2; ++i) ra[i] = *(const v4u*)(gA + (size_t)(i * 64) * lda);
#pragma unroll
    for (int i = 0; i < 4; ++i) rb[i] = *(const v4u*)(gB + (size_t)(i * 64) * ldb);
#pragma unroll
    for (int i = 0; i < 2; ++i) *(v4u*)(sA + soff + i * 64 * 32) = ra[i];
#pragma unroll
    for (int i = 0; i < 4; ++i) *(v4u*)(sB + soff + i * 64 * 32) = rb[i];
    __syncthreads();
#pragma unroll 1
    for (int kt = 0; kt < nk; kt += 2) {
#pragma unroll
        for (int hf = 0; hf < 2; ++hf) {
            const int kn = (kt + hf + 1 < nk) ? kt + hf + 1 : kt + hf;
#pragma unroll
            for (int i = 0; i < 2; ++i) ra[i] = *(const v4u*)(gA + (size_t)(i * 64) * lda + kn * 32);
#pragma unroll
            for (int i = 0; i < 4; ++i) rb[i] = *(const v4u*)(gB + (size_t)(i * 64) * ldb + kn * 32);
            __builtin_amdgcn_sched_barrier(0);
            __builtin_amdgcn_s_setprio(1);
            {
                const bf16_t* pa = pa0 + hf * SB; const bf16_t* pb = pb0 + hf * SA;
                bf16x8 bfr[4];
#pragma unroll
                for (int j = 0; j < 4; ++j) bfr[j] = *(const bf16x8*)(pb + j * 16 * 32);
#pragma unroll
                for (int ih = 0; ih < 2; ++ih) {
                    bf16x8 af[4];
#pragma unroll
                    for (int i = 0; i < 4; ++i) af[i] = *(const bf16x8*)(pa + (ih * 4 + i) * 16 * 32);
#pragma unroll
                    for (int i = 0; i < 4; ++i)
#pragma unroll
                        for (int j = 0; j < 4; ++j) acc[ih * 4 + i][j] = MFMA(af[i], bfr[j], acc[ih * 4 + i][j]);
                }
            }
            __builtin_amdgcn_s_setprio(0);
            {
                bf16_t* dA = sA + (hf ^ 1) * SA + soff; bf16_t* dB = sB + (hf ^ 1) * SB + soff;
#pragma unroll
                for (int i = 0; i < 2; ++i) *(v4u*)(dA + i * 64 * 32) = ra[i];
#pragma unroll
                for (int i = 0; i < 4; ++i) *(v4u*)(dB + i * 64 * 32) = rb[i];
            }
            __syncthreads();
        }
    }
}

template <int NI>
__device__ __forceinline__ void zero_acc(f32x4 (&acc)[NI][4]) {
#pragma unroll
    for (int i = 0; i < NI; ++i)
#pragma unroll
        for (int j = 0; j < 4; ++j) acc[i][j] = (f32x4){0.f, 0.f, 0.f, 0.f};
}

__device__ __forceinline__ void transpose_group(const Params& p, unsigned char* smem, int grp) {
    unsigned char* ws = p.ws;
    const int tid = opaque_tid();
    float* tl = (float*)smem;
    {

            const int tile = grp * 4;
            const float* src; bf16_t* dst; int K, stride, col0, lt, ntn;
            if (tile < 512)       { src = p.in[3];  dst = (bf16_t*)(ws + OFF_W1);  K = 1024; stride = 6664; col0 = 0;    lt = tile;        ntn = 32; }
            else if (tile < 1664) { src = p.in[3];  dst = (bf16_t*)(ws + OFF_W1) + (size_t)2048 * 1024; K = 1024; stride = 6664; col0 = 2056; lt = tile - 512; ntn = 72; }
            else if (tile < 2432) { src = p.in[20]; dst = (bf16_t*)(ws + OFF_WG);  K = 1024; stride = 3072; col0 = 0; lt = tile - 1664; ntn = 48; }
            else if (tile < 2688) { src = p.in[22]; dst = (bf16_t*)(ws + OFF_WPM); K = 1024; stride = 1024; col0 = 0; lt = tile - 2432; ntn = 16; }
            else if (tile < 2944) { src = p.in[23]; dst = (bf16_t*)(ws + OFF_WPD); K = 1024; stride = 1024; col0 = 0; lt = tile - 2688; ntn = 16; }
            else if (tile < 3200) { src = p.in[24]; dst = (bf16_t*)(ws + OFF_WPC); K = 1024; stride = 1024; col0 = 0; lt = tile - 2944; ntn = 16; }
            else if (tile < 3456) { src = p.in[25]; dst = (bf16_t*)(ws + OFF_WOUT); K = 1024; stride = 1024; col0 = 0; lt = tile - 3200; ntn = 16; }
            else if (tile < 4480) { src = p.in[27]; dst = (bf16_t*)(ws + OFF_WUP); K = 1024; stride = 4096; col0 = 0; lt = tile - 3456; ntn = 64; }
            else if (tile < 5504) { src = p.in[28]; dst = (bf16_t*)(ws + OFF_WDN); K = 4096; stride = 1024; col0 = 0; lt = tile - 4480; ntn = 16; }
            else                  { src = p.in[19]; dst = (bf16_t*)(ws + OFF_WMKV); K = 1024; stride = 1536; col0 = 0; lt = tile - 5504; ntn = 24; }
            const bool scale_up = (tile >= 3456 && tile < 4480);
            const int tn = lt % ntn, tk = lt / ntn, n0 = tn * 64, k0 = tk * 64;
            const int kr = tid >> 4, n4 = (tid & 15) * 4;
            float4 v[4][4];
#pragma unroll
            for (int j = 0; j < 4; ++j)
#pragma unroll
                for (int i = 0; i < 4; ++i) v[j][i] = *(const float4*)(src + (size_t)(k0 + kr + 16 * i) * stride + col0 + n0 + j * 64 + n4);
            const int nn = tid >> 2, kq = tid & 3;
            float gs[16];
#pragma unroll
            for (int e = 0; e < 16; ++e) gs[e] = scale_up ? p.in[26][k0 + kq * 16 + e] : 1.0f;
#pragma unroll
            for (int j = 0; j < 4; ++j) {
                __syncthreads();
#pragma unroll
                for (int i = 0; i < 4; ++i) { float* d = tl + (kr + 16 * i) * 65 + n4; d[0] = v[j][i].x; d[1] = v[j][i].y; d[2] = v[j][i].z; d[3] = v[j][i].w; }
                __syncthreads();
                float f[16];
#pragma unroll
                for (int e = 0; e < 16; ++e) f[e] = tl[(kq * 16 + e) * 65 + nn] * gs[e];
                v4u o0, o1;
                o0.x = pack2(f[0], f[1]); o0.y = pack2(f[2], f[3]); o0.z = pack2(f[4], f[5]); o0.w = pack2(f[6], f[7]);
                o1.x = pack2(f[8], f[9]); o1.y = pack2(f[10], f[11]); o1.z = pack2(f[12], f[13]); o1.w = pack2(f[14], f[15]);
                bf16_t* dp = dst + (size_t)(n0 + j * 64 + nn) * K + k0 + kq * 16;
                *(v4u*)dp = o0; *(v4u*)(dp + 8) = o1;
            }
            }
}

__device__ void phase0(const Params& p, unsigned char* smem) {
    const int tid = opaque_tid(), lane = tid & 63, w = tid >> 6;
    unsigned char* ws = p.ws;
    {
        for (int k = blockIdx.x; k < 512; k += gridDim.x) transpose_group(p, smem, k < 416 ? k : 1376 + (k - 416));
        __syncthreads();
    }
    {
        float* sg = (float*)smem;
        const float* win = p.in[3];
#pragma unroll
        for (int i = 0; i < 8; ++i) { const int id = tid + i * 256, k = id >> 1, hf = id & 1; *(float4*)(sg + k * 8 + hf * 4) = *(const float4*)(win + (size_t)k * 6664 + 2048 + hf * 4); }
        __syncthreads();
        const float* g1 = p.in[2]; const float* gm = p.in[18];
        bf16_t* H = (bf16_t*)((unsigned char*)p.out + OUT_H);
        bf16_t* HM = (bf16_t*)(ws + OFF_HMEM);
        float* IG = (float*)(ws + OFF_IG); float* LF = (float*)(ws + OFF_LF);
        const int rstride = gridDim.x * 4;
        float4 vn[4], vn2[4];
        {
            const int row = blockIdx.x * 4 + w;
            const float* src = (row >= T_TOK) ? (p.in[1] + (size_t)(row - T_TOK) * 1024) : (p.in[0] + (size_t)row * 1024);
            const int row2 = (row + rstride < T_TOK + 1024) ? row + rstride : row;
            const float* src2 = (row2 >= T_TOK) ? (p.in[1] + (size_t)(row2 - T_TOK) * 1024) : (p.in[0] + (size_t)row2 * 1024);
#pragma unroll
            for (int i = 0; i < 4; ++i) { vn[i] = *(const float4*)(src + lane * 4 + 256 * i); vn2[i] = *(const float4*)(src2 + lane * 4 + 256 * i); }
        }
        for (int row = blockIdx.x * 4 + w; row < T_TOK + 1024; row += rstride) {
            const bool ismem = row >= T_TOK;
            const float* g = ismem ? gm : g1;
            bf16_t* dst = ismem ? (HM + (size_t)(row - T_TOK) * 1024) : (H + (size_t)row * 1024);
            float4 v[4]; float ss = 0.f;
#pragma unroll
            for (int i = 0; i < 4; ++i) { v[i] = vn[i]; vn[i] = vn2[i]; ss += v[i].x * v[i].x + v[i].y * v[i].y + v[i].z * v[i].z + v[i].w * v[i].w; }
            {
                const int rn = (row + 2 * rstride < T_TOK + 1024) ? row + 2 * rstride : row;
                const float* srcn = (rn >= T_TOK) ? (p.in[1] + (size_t)(rn - T_TOK) * 1024) : (p.in[0] + (size_t)rn * 1024);
#pragma unroll
                for (int i = 0; i < 4; ++i) vn2[i] = *(const float4*)(srcn + lane * 4 + 256 * i);
            }
            ss = wave_sum(ss);
            const float rstd = rsqrtf(ss * (1.0f / 1024.0f) + EPS);
            float ga[8];
#pragma unroll
            for (int c = 0; c < 8; ++c) ga[c] = 0.f;
#pragma unroll
            for (int i = 0; i < 4; ++i) {
                const int k = lane * 4 + 256 * i;
                const float4 gg = *(const float4*)(g + k);
                float hv[4] = {v[i].x * rstd * gg.x, v[i].y * rstd * gg.y, v[i].z * rstd * gg.z, v[i].w * rstd * gg.w};
                uint2 o; o.x = pack2(hv[0], hv[1]); o.y = pack2(hv[2], hv[3]);
                *(uint2*)(dst + k) = o;
                if (!ismem) {
#pragma unroll
                    for (int e = 0; e < 4; ++e) {
                        const float4 w0 = *(const float4*)(sg + (k + e) * 8), w1 = *(const float4*)(sg + (k + e) * 8 + 4);
                        ga[0] += hv[e] * w0.x; ga[1] += hv[e] * w0.y; ga[2] += hv[e] * w0.z; ga[3] += hv[e] * w0.w;
                        ga[4] += hv[e] * w1.x; ga[5] += hv[e] * w1.y; ga[6] += hv[e] * w1.z; ga[7] += hv[e] * w1.w;
                    }
                }
            }
            if (!ismem) {
#pragma unroll
                for (int c = 0; c < 8; ++c) ga[c] = wave_sum(ga[c]);
                if (lane == 0) {
#pragma unroll
                    for (int hd = 0; hd < 4; ++hd) {
                        IG[(size_t)row * 4 + hd] = ga[hd] + p.in[4][hd];
                        const float xf = ga[4 + hd] + p.in[5][hd];
                        LF[(size_t)row * 4 + hd] = fminf(xf, 0.f) - log1pf(__expf(-fabsf(xf)));
                    }
                }
            }
        }
    }
}

__device__ void phase1(const Params& p, unsigned char* smem) {
    unsigned char* ws = p.ws;
    const int tid = opaque_tid(), lane = tid & 63, w = tid >> 6, r16 = lane & 15, q = lane >> 4, wa = w & 1, wb = w >> 1;
    bf16_t* PROJ = (bf16_t*)(ws + OFF_PROJ);
    const bf16_t* H = (const bf16_t*)((unsigned char*)p.out + OUT_H);
    bf16_t* TMP = (bf16_t*)((unsigned char*)p.out + OUT_TMP);
    const int NT1 = 52, NTILES = 256 * NT1, NMEM = 8 * 12;
    for (int tile = blockIdx.x; tile < NTILES + NMEM; tile += gridDim.x) {
        f32x4 acc[4][4]; zero_acc<4>(acc);
        if (tile < NTILES) {
            int mt, nt; map_tile(tile, NT1, mt, nt);
            const int m0 = mt * 128, n0 = nt * 128;
            gemm_acc<128, false>(acc, H + (size_t)m0 * 1024, 1024, (const bf16_t*)(ws + OFF_W1) + (size_t)n0 * 1024, 1024, 1024, smem);
            const bool is_mv = (n0 >= C_MV && n0 < C_MO), is_dv = (n0 >= C_DV && n0 < C_CQ);
            if (!is_mv && !is_dv) {
                if (n0 >= C_DQ && n0 < C_DV) {
                    const bool isk = n0 >= C_DK;
                    const float* gn = isk ? p.in[10] : p.in[9];
                    const float sc = isk ? 1.0f : 0.125f * 1.4426950408889634f;
                    float gv[4][4];
#pragma unroll
                    for (int i = 0; i < 4; ++i) { const float4 g4 = *(const float4*)(gn + i * 16 + nq_of(q)); gv[i][0] = g4.x; gv[i][1] = g4.y; gv[i][2] = g4.z; gv[i][3] = g4.w; }
#pragma unroll
                    for (int j = 0; j < 4; ++j) {
                        float ss = 0.f;
#pragma unroll
                        for (int i = 0; i < 4; ++i) ss += acc[i][j][0] * acc[i][j][0] + acc[i][j][1] * acc[i][j][1] + acc[i][j][2] * acc[i][j][2] + acc[i][j][3] * acc[i][j][3];
                        ss += __shfl_xor(ss, 16); ss += __shfl_xor(ss, 32);
                        const float rs = rsqrtf(ss * (1.0f / 64.0f) + EPS) * sc;
#pragma unroll
                        for (int i = 0; i < 4; ++i) { acc[i][j][0] *= rs * gv[i][0]; acc[i][j][1] *= rs * gv[i][1]; acc[i][j][2] *= rs * gv[i][2]; acc[i][j][3] *= rs * gv[i][3]; }
                    }
                }
                if (n0 >= C_CQ) {
                    float* xs = (float*)smem;
                    float ssj[4];
#pragma unroll
                    for (int j = 0; j < 4; ++j) {
                        float ss = 0.f;
#pragma unroll
                        for (int i = 0; i < 4; ++i) ss += acc[i][j][0] * acc[i][j][0] + acc[i][j][1] * acc[i][j][1] + acc[i][j][2] * acc[i][j][2] + acc[i][j][3] * acc[i][j][3];
                        ss += __shfl_xor(ss, 16); ss += __shfl_xor(ss, 32);
                        ssj[j] = ss;
                        if (q == 0) xs[wa * 128 + wb * 64 + j * 16 + r16] = ss;
                    }
                    __syncthreads();
                    float gv[4][4];
#pragma unroll
                    for (int i = 0; i < 4; ++i) { const float4 g4 = *(const float4*)(p.in[16] + wa * 64 + i * 16 + nq_of(q)); gv[i][0] = g4.x; gv[i][1] = g4.y; gv[i][2] = g4.z; gv[i][3] = g4.w; }
#pragma unroll
                    for (int j = 0; j < 4; ++j) {
                        const float tot = ssj[j] + xs[(wa ^ 1) * 128 + wb * 64 + j * 16 + r16];
                        const float rs = rsqrtf(tot * (1.0f / 128.0f) + EPS) * (0.08838834764831845f * 1.4426950408889634f);
#pragma unroll
                        for (int i = 0; i < 4; ++i) { acc[i][j][0] *= rs * gv[i][0]; acc[i][j][1] *= rs * gv[i][1]; acc[i][j][2] *= rs * gv[i][2]; acc[i][j][3] *= rs * gv[i][3]; }
                    }
                    __syncthreads();
                }
#pragma unroll
                for (int i = 0; i < 4; i += 2)
#pragma unroll
                    for (int j = 0; j < 4; ++j) {
                        const int n = n0 + wa * 64 + (i + (q >> 1)) * 16 + 8 * (q & 1), m = m0 + wb * 64 + j * 16 + r16;
                        unsigned ax = pack2(acc[i][j][0], acc[i][j][1]), ay = pack2(acc[i][j][2], acc[i][j][3]);
                        unsigned bx = pack2(acc[i + 1][j][0], acc[i + 1][j][1]), by = pack2(acc[i + 1][j][2], acc[i + 1][j][3]);
                        { auto r_ = __builtin_amdgcn_permlane32_swap(ax, bx, false, false); ax = r_[0]; bx = r_[1]; }
                        { auto r_ = __builtin_amdgcn_permlane32_swap(ay, by, false, false); ay = r_[0]; by = r_[1]; }
                        v4u o; o.x = ax; o.y = ay; o.z = bx; o.w = by;
                        if (n0 < 1024) *(v4u*)(TMP + (size_t)m * 1024 + n) = o;
                        else           *(v4u*)(PROJ + (size_t)m * LDP + n) = o;
                    }
            } else
#pragma unroll
            for (int i = 0; i < 4; ++i)
#pragma unroll
                for (int j = 0; j < 4; ++j) {
                    const int n = n0 + wa * 64 + i * 16 + nq_of(q), m = m0 + wb * 64 + j * 16 + r16;
                    const f32x4 a = acc[i][j];
                    if (is_mv) {
                        const int vv = (n - C_MV) & 255, hd = (n - C_MV) >> 8, mband = m & ~63, key = m & 63;
                        bf16_t* d = PROJ + (size_t)(mband + (vv >> 2)) * LDP + C_MV + hd * 256 + key;
                        d[0] = f2bf(a[0]); d[64] = f2bf(a[1]); d[128] = f2bf(a[2]); d[192] = f2bf(a[3]);
                    } else if (is_dv) {
                        const int vv = (n - C_DV) & 127, hd = (n - C_DV) >> 7, mband = m & ~63, key = m & 63;
                        bf16_t* d0 = PROJ + (size_t)(mband + (vv >> 1)) * LDP + C_DV + hd * 128 + key;
                        bf16_t* d1 = d0 + LDP;
                        d0[0] = f2bf(a[0]); d0[64] = f2bf(a[1]); d1[0] = f2bf(a[2]); d1[64] = f2bf(a[3]);
                    } else {
                        uint2 o; o.x = pack2(a[0], a[1]); o.y = pack2(a[2], a[3]);
                        if (n0 < 1024) *(uint2*)(TMP + (size_t)m * 1024 + n) = o;
                        else           *(uint2*)(PROJ + (size_t)m * LDP + n) = o;
                    }
                }
        } else {
            const int lt = tile - NTILES, mt = lt / 12, nt = lt % 12, m0 = mt * 128, n0 = nt * 128;
            gemm_acc<128, false>(acc, (const bf16_t*)(ws + OFF_HMEM) + (size_t)m0 * 1024, 1024, (const bf16_t*)(ws + OFF_WMKV) + (size_t)n0 * 1024, 1024, 1024, smem);
            bf16_t* MKN = (bf16_t*)(ws + OFF_MKN); bf16_t* VTC = (bf16_t*)(ws + OFF_VTC);
#pragma unroll
            for (int i = 0; i < 4; ++i)
#pragma unroll
                for (int j = 0; j < 4; ++j) {
                    const int n = n0 + wa * 64 + i * 16 + nq_of(q), m = m0 + wb * 64 + j * 16 + r16;
                    const f32x4 a = acc[i][j];
                    if (n0 < 512) { uint2 o; o.x = pack2(a[0], a[1]); o.y = pack2(a[2], a[3]); *(uint2*)(MKN + (size_t)m * 512 + n) = o; }
                    else {
                        const int vi = n - 512, hc = vi >> 8, v = vi & 255, b = m >> 8, mi = m & 255;
                        bf16_t* d = VTC + ((size_t)((b * 4 + hc) * 256 + v)) * 256 + mi;
                        d[0] = f2bf(a[0]); d[256] = f2bf(a[1]); d[512] = f2bf(a[2]); d[768] = f2bf(a[3]);
                    }
                }
        }
    }
    {
        const int nlate = (NTILES + NMEM) % (int)gridDim.x;
        const int nfree = (int)gridDim.x - nlate;
        if ((int)blockIdx.x >= nlate && nfree > 0) {
            for (int k = (int)blockIdx.x - nlate; k < 960; k += nfree) transpose_group(p, smem, 416 + k);
        } else if (nfree <= 0) {
            for (int k = blockIdx.x; k < 960; k += gridDim.x) transpose_group(p, smem, 416 + k);
        }
    }
}

template <int LANES>
__device__ __forceinline__ void norm_group(bf16_t* ptr, const float* gain, int sub, float scale) {
    uint4 v = *(const uint4*)ptr; float f[8]; unpack8(v, f);
    float ss = 0.f;
#pragma unroll
    for (int e = 0; e < 8; ++e) ss += f[e] * f[e];
#pragma unroll
    for (int m = 1; m < LANES; m <<= 1) ss += __shfl_xor(ss, m);
    const float rstd = rsqrtf(ss * (1.0f / (8 * LANES)) + EPS) * scale;
#pragma unroll
    for (int e = 0; e < 8; ++e) f[e] = f[e] * rstd * gain[sub * 8 + e];
    *(uint4*)ptr = pack8(f);
}

__device__ void phase2a(const Params& p, unsigned char* smem) {
    unsigned char* ws = p.ws;
    const int tid = opaque_tid(), lane = tid & 63, w = tid >> 6;
    bf16_t* PROJ = (bf16_t*)(ws + OFF_PROJ);
    const float* IG = (const float*)(ws + OFF_IG); const float* LF = (const float*)(ws + OFF_LF);
    float* BCUM = (float*)(ws + OFF_BCUM); float* MPREV = (float*)(ws + OFF_MPREV); float* MNEW = (float*)(ws + OFF_MNEW);
    {
        const int seq = blockIdx.x * 4 + w;
        if (seq < 16) {
            const int b = seq >> 2, hd = seq & 3;
            float m = 0.f;
            const size_t tb = ((size_t)(b * SEQ + 2 * lane)) * 4 + hd;
            float nl0 = LF[tb], nl1 = LF[tb + 4], ni0 = IG[tb], ni1 = IG[tb + 4];
#pragma unroll 1
            for (int c = 0; c < 64; ++c) {
                const float l0 = nl0, l1 = nl1, i0 = ni0, i1 = ni1;
                {
                    const size_t tn = tb + (size_t)((c < 63 ? c + 1 : c) * 128) * 4;
                    nl0 = LF[tn]; nl1 = LF[tn + 4]; ni0 = IG[tn]; ni1 = IG[tn + 4];
                }
                const float s = l0 + l1; float inc = s;
#pragma unroll
                for (int d = 1; d < 64; d <<= 1) { const float o = __shfl_up(inc, d); if (lane >= d) inc += o; }
                const float bc0 = inc - s + l0, bc1 = inc;
                BCUM[(size_t)seq * SEQ + c * 128 + 2 * lane] = bc0; BCUM[(size_t)seq * SEQ + c * 128 + 2 * lane + 1] = bc1;
                const float amax = wave_max(fmaxf(i0 - bc0, i1 - bc1));
                const float bend = __shfl(inc, 63);
                if (lane == 0) MPREV[seq * 64 + c] = m;
                m = bend + fmaxf(m, amax);
                if (lane == 0) MNEW[seq * 64 + c] = m;
            }
        }
    }
    const int nscan = gridDim.x > 8 ? 4 : 0;
    if ((int)blockIdx.x < nscan) return;
    const int gtid = ((int)blockIdx.x - nscan) * 256 + tid, gstride = ((int)gridDim.x - nscan) * 256;
    {
        const bf16_t* TMP = (const bf16_t*)((unsigned char*)p.out + OUT_TMP);
        const float* cw = p.in[6]; const float* cb = p.in[7];
        for (int idx = gtid; idx < T_TOK * 128; idx += gstride) {
            const int t = idx >> 7, c0 = (idx & 127) * 8, s = t & (SEQ - 1);
            float y[8];
#pragma unroll
            for (int e = 0; e < 8; ++e) y[e] = cb[c0 + e];
#pragma unroll
            for (int j = 0; j < 4; ++j) {
                if (s - 3 + j >= 0) {
                    const uint4 rv = *(const uint4*)(TMP + (size_t)(t - 3 + j) * 1024 + c0);
                    float f[8]; unpack8(rv, f);
#pragma unroll
                    for (int e = 0; e < 8; ++e) y[e] += f[e] * cw[j * 1024 + c0 + e];
                }
            }
            const float sc = (c0 < 512) ? 0.08838834764831845f : 1.0f;
#pragma unroll
            for (int e = 0; e < 8; ++e) y[e] = y[e] * sigmoidf_(y[e]) * sc;
            *(uint4*)(PROJ + (size_t)t * LDP + c0) = pack8(y);
        }
    }
    {
        bf16_t* MKN = (bf16_t*)(ws + OFF_MKN);
        for (int idx = gtid; idx < 1024 * 64; idx += gstride) {
            const int r = idx >> 6, cc = idx & 63, sub = cc & 15;
            norm_group<16>(MKN + (size_t)r * 512 + cc * 8, p.in[17], sub, 1.0f);
        }
    }
}

__device__ void phase2b(const Params& p, unsigned char* smem) {
    unsigned char* ws = p.ws;
    const int tid = opaque_tid(), lane = tid & 63, w = tid >> 6, r16 = lane & 15, q = lane >> 4, wa = w & 1, wb = w >> 1;
    const bf16_t* PROJ = (const bf16_t*)(ws + OFF_PROJ);
    const float* IG = (const float*)(ws + OFF_IG); const float* BCUM = (const float*)(ws + OFF_BCUM); const float* MNEW = (const float*)(ws + OFF_MNEW);
    bf16_t* CST = (bf16_t*)((unsigned char*)p.out + OUT_TMP); float* NST = (float*)(ws + OFF_NST);
    bf16_t* sV = (bf16_t*)smem; bf16_t* sK = sV + 128 * 136; float* sw = (float*)(smem + 69632);
    for (int task = blockIdx.x; task < 2048; task += gridDim.x) {
        const int tid = opaque_tid(), lane = tid & 63, w = tid >> 6, r16 = lane & 15, q = lane >> 4, wa = w & 1, wb = w >> 1;
        const int vh = task & 1, bhc = task >> 1, c = bhc & 63, bh = bhc >> 6, hd = bh & 3, b = bh >> 2, t0 = b * SEQ + c * 128;
        __syncthreads();
        if (tid < 128) {
            const float bc = BCUM[(size_t)bh * SEQ + c * 128 + tid], bend = BCUM[(size_t)bh * SEQ + c * 128 + 127];
            sw[tid] = __expf(bend - bc + IG[(size_t)(t0 + tid) * 4 + hd] - MNEW[bhc]);
        }
        __syncthreads();
#pragma unroll
        for (int i = 0; i < 8; ++i) {
            const int id = tid + i * 256, bb = id >> 10, rr = (id >> 5) & 31, cc = id & 31;
            const int r = vh * 32 + rr, vv = 4 * rr + (cc >> 3), key = bb * 64 + (cc & 7) * 8;
            *(uint4*)(sV + vv * 136 + key) = *(const uint4*)(PROJ + (size_t)(t0 + bb * 64 + r) * LDP + C_MV + hd * 256 + cc * 8);
        }
#pragma unroll
        for (int i = 0; i < 8; ++i) {
            const int id = tid + i * 256, s = id >> 4, cc = id & 15;
            const uint4 kv = *(const uint4*)(PROJ + (size_t)(t0 + s) * LDP + C_MK + hd * 128 + cc * 8);
            float f[8]; unpack8(kv, f); const float ww = sw[s];
#pragma unroll
            for (int e = 0; e < 8; ++e) sK[(cc * 8 + e) * 136 + s] = f2bf(f[e] * ww);
        }
        __syncthreads();
        f32x4 acc[4][4]; zero_acc<4>(acc);
#pragma unroll
        for (int ks = 0; ks < 4; ++ks) {
            bf16x8 af[4], bfr[4];
#pragma unroll
            for (int i = 0; i < 4; ++i) af[i] = *(const bf16x8*)(sK + (wa * 64 + i * 16 + r16) * 136 + ks * 32 + q * 8);
#pragma unroll
            for (int j = 0; j < 4; ++j) bfr[j] = *(const bf16x8*)(sV + (wb * 64 + j * 16 + r16) * 136 + ks * 32 + q * 8);
#pragma unroll
            for (int i = 0; i < 4; ++i)
#pragma unroll
                for (int j = 0; j < 4; ++j) acc[i][j] = MFMA(af[i], bfr[j], acc[i][j]);
        }
#pragma unroll
        for (int i = 0; i < 4; ++i)
#pragma unroll
            for (int j = 0; j < 4; ++j) {
                const int d = wa * 64 + i * 16 + 4 * q, v = vh * 128 + wb * 64 + j * 16 + r16;
                uint2 o; o.x = pack2(acc[i][j][0], acc[i][j][1]); o.y = pack2(acc[i][j][2], acc[i][j][3]);
                *(uint2*)(CST + ((size_t)bhc * 256 + v) * 128 + d) = o;
            }
        if (vh == 0 && tid < 128) {
            float sm = 0.f;
#pragma unroll
            for (int s8 = 0; s8 < 16; ++s8) {
                const uint4 kv = *(const uint4*)(sK + tid * 136 + s8 * 8); float f[8]; unpack8(kv, f);
                sm += ((f[0] + f[1]) + (f[2] + f[3])) + ((f[4] + f[5]) + (f[6] + f[7]));
            }
            NST[(size_t)bhc * 128 + tid] = sm;
        }
    }
}

__device__ void phase2c(const Params& p) {
    unsigned char* ws = p.ws;
    const float* BCUM = (const float*)(ws + OFF_BCUM); const float* MPREV = (const float*)(ws + OFF_MPREV); const float* MNEW = (const float*)(ws + OFF_MNEW);
    bf16_t* CST = (bf16_t*)((unsigned char*)p.out + OUT_TMP); float* NST = (float*)(ws + OFF_NST);
    const int gtid = blockIdx.x * 256 + threadIdx.x, gstride = gridDim.x * 256;
    for (int idx = gtid; idx < 16 * 4096 + 16 * 128; idx += gstride) {
        if (idx < 16 * 4096) {
            const int bh = idx >> 12, e8 = idx & 4095;
            float st[8];
#pragma unroll
            for (int e = 0; e < 8; ++e) st[e] = 0.f;
#pragma unroll 4
            for (int c = 0; c < 64; ++c) {
                const int bhc = bh * 64 + c;
                uint4* ptr = (uint4*)(CST + (size_t)bhc * 32768 + e8 * 8);
                const uint4 dv = *ptr; float f[8]; unpack8(dv, f);
                *ptr = pack8(st);
                const float decay = __expf(BCUM[(size_t)bh * SEQ + c * 128 + 127] + MPREV[bhc] - MNEW[bhc]);
#pragma unroll
                for (int e = 0; e < 8; ++e) st[e] = decay * st[e] + f[e];
            }
        } else {
            const int i2 = idx - 16 * 4096, bh = i2 >> 7, d = i2 & 127;
            float st = 0.f;
            for (int c = 0; c < 64; ++c) {
                const int bhc = bh * 64 + c;
                float* ptr = NST + (size_t)bhc * 128 + d;
                const float dn = *ptr; *ptr = st;
                const float decay = __expf(BCUM[(size_t)bh * SEQ + c * 128 + 127] + MPREV[bhc] - MNEW[bhc]);
                st = decay * st + dn;
            }
        }
    }
}

__device__ void phase2d(const Params& p, unsigned char* smem) {
    unsigned char* ws = p.ws;
    const int tid = opaque_tid(), lane = tid & 63, w = tid >> 6, r16 = lane & 15, q = lane >> 4;
    bf16_t* PROJ = (bf16_t*)(ws + OFF_PROJ);
    const float* IG = (const float*)(ws + OFF_IG); const float* BCUM = (const float*)(ws + OFF_BCUM); const float* MPREV = (const float*)(ws + OFF_MPREV);
    const bf16_t* CST = (const bf16_t*)((unsigned char*)p.out + OUT_TMP); const float* NST = (const float*)(ws + OFF_NST);
    const float* gmn = p.in[8];
    bf16_t* sQ = (bf16_t*)smem; bf16_t* sK = sQ + 128 * 136;
    float* aS = (float*)(smem + 69632); float* Mj = aS + 128; float* bcS = Mj + 128; float* nS = bcS + 128;
    for (int task = blockIdx.x; task < 1024; task += gridDim.x) {
        const int tid = opaque_tid(), lane = tid & 63, w = tid >> 6, r16 = lane & 15, q = lane >> 4;
        const int bhc = task, c = bhc & 63, bh = bhc >> 6, hd = bh & 3, b = bh >> 2, t0 = b * SEQ + c * 128;
        const float mprev = MPREV[bhc];
        __syncthreads();
        if (tid < 128) {
            const float bc = BCUM[(size_t)bh * SEQ + c * 128 + tid];
            aS[tid] = IG[(size_t)(t0 + tid) * 4 + hd] - bc; bcS[tid] = bc; nS[tid] = NST[(size_t)bhc * 128 + tid];
        }
#pragma unroll
        for (int i = 0; i < 8; ++i) {
            const int id = tid + i * 256, row = id >> 4, cc = id & 15;
            *(uint4*)(sQ + row * 136 + cc * 8) = *(const uint4*)(PROJ + (size_t)(t0 + row) * LDP + C_MQ + hd * 128 + cc * 8);
            *(uint4*)(sK + row * 136 + cc * 8) = *(const uint4*)(PROJ + (size_t)(t0 + row) * LDP + C_MK + hd * 128 + cc * 8);
        }
        __syncthreads();
        if (tid < 128) {
            float pm = -3.0e38f;
            const int nfull = (tid + 1) >> 2;
            for (int s4 = 0; s4 < nfull; ++s4) { const float4 a4 = *(const float4*)(aS + 4 * s4); pm = fmaxf(fmaxf(pm, fmaxf(a4.x, a4.y)), fmaxf(a4.z, a4.w)); }
            for (int s = 4 * nfull; s <= tid; ++s) pm = fmaxf(pm, aS[s]);
            Mj[tid] = fmaxf(mprev, pm);
        }
        __syncthreads();
        bf16x8 fS[2][4], fQ[2][4];
        float dsum[2] = {0.f, 0.f}, qn[2] = {0.f, 0.f}, Ml[2];
        Ml[0] = Mj[32 * w + r16]; Ml[1] = Mj[32 * w + 16 + r16];
#pragma unroll
        for (int kp = 0; kp < 4; ++kp) {
            f32x4 sa[2][2];
#pragma unroll
            for (int hf = 0; hf < 2; ++hf) { sa[hf][0] = (f32x4){0.f, 0.f, 0.f, 0.f}; sa[hf][1] = (f32x4){0.f, 0.f, 0.f, 0.f}; }
#pragma unroll
            for (int ks = 0; ks < 4; ++ks) {
                const bf16x8 q0 = *(const bf16x8*)(sQ + (32 * w + r16) * 136 + ks * 32 + q * 8);
                const bf16x8 q1 = *(const bf16x8*)(sQ + (32 * w + 16 + r16) * 136 + ks * 32 + q * 8);
#pragma unroll
                for (int hf = 0; hf < 2; ++hf) {
                    const bf16x8 kf = *(const bf16x8*)(sK + ((2 * kp + hf) * 16 + r16) * 136 + ks * 32 + q * 8);
                    sa[hf][0] = MFMA(kf, q0, sa[hf][0]); sa[hf][1] = MFMA(kf, q1, sa[hf][1]);
                }
            }
#pragma unroll
            for (int hf = 0; hf < 2; ++hf)
#pragma unroll
                for (int jt = 0; jt < 2; ++jt)
#pragma unroll
                    for (int rr = 0; rr < 4; ++rr) {
                        const int s = (2 * kp + hf) * 16 + 4 * q + rr, j = 32 * w + 16 * jt + r16;
                        const float val = (s <= j) ? sa[hf][jt][rr] * __expf(aS[s] - Ml[jt]) : 0.f;
                        dsum[jt] += val;
                        fS[jt][kp][hf * 4 + rr] = (short)f2bf(val);
                    }
            __builtin_amdgcn_sched_barrier(0);
        }
        float rden[2];
#pragma unroll
        for (int jt = 0; jt < 2; ++jt) {
            const float wi = __expf(mprev - Ml[jt]);
#pragma unroll
            for (int ks = 0; ks < 4; ++ks) {
                const bf16x8 qf = *(const bf16x8*)(sQ + (32 * w + 16 * jt + r16) * 136 + ks * 32 + q * 8);
#pragma unroll
                for (int e = 0; e < 8; ++e) {
                    const float f = bf2f((bf16_t)qf[e]) * wi;
                    qn[jt] += f * nS[ks * 32 + q * 8 + e];
                    fQ[jt][ks][e] = (short)f2bf(f);
                }
            }
            float den = dsum[jt] + qn[jt];
            den += __shfl_xor(den, 16); den += __shfl_xor(den, 32);
            const float mloc = bcS[32 * w + 16 * jt + r16] + Ml[jt];
            rden[jt] = 1.0f / fmaxf(fabsf(den), __expf(-mloc));
        }
        float ssq[2] = {0.f, 0.f};
#pragma unroll 1
        for (int vq = 0; vq < 4; ++vq) {
            __syncthreads();
#pragma unroll
            for (int i = 0; i < 4; ++i) {
                const int id = tid + i * 256, bb = id >> 9, rr = (id >> 5) & 15, cc = id & 31;
                const int r = vq * 16 + rr, vv = 4 * rr + (cc >> 3), key = bb * 64 + (cc & 7) * 8;
                *(uint4*)(sQ + vv * 136 + key) = *(const uint4*)(PROJ + (size_t)(t0 + bb * 64 + r) * LDP + C_MV + hd * 256 + cc * 8);
            }
#pragma unroll
            for (int i = 0; i < 4; ++i) {
                const int id = tid + i * 256, vv = id >> 4, cc = id & 15;
                *(uint4*)(sK + vv * 136 + cc * 8) = *(const uint4*)(CST + ((size_t)bhc * 256 + vq * 64 + vv) * 128 + cc * 8);
            }
            __syncthreads();
#pragma unroll
            for (int vt = 0; vt < 4; ++vt) {
                f32x4 o[2]; o[0] = (f32x4){0.f, 0.f, 0.f, 0.f}; o[1] = (f32x4){0.f, 0.f, 0.f, 0.f};
#pragma unroll
                for (int kp = 0; kp < 4; ++kp) {
                    const bf16_t* vp = sQ + (vt * 16 + r16) * 136 + kp * 32 + 4 * q;
                    const uint2 lo = *(const uint2*)vp, hi = *(const uint2*)(vp + 16);
                    uint4 cm; cm.x = lo.x; cm.y = lo.y; cm.z = hi.x; cm.w = hi.y;
                    const bf16x8 vf = *(const bf16x8*)&cm;
                    o[0] = MFMA(vf, fS[0][kp], o[0]); o[1] = MFMA(vf, fS[1][kp], o[1]);
                }
#pragma unroll
                for (int ks = 0; ks < 4; ++ks) {
                    const bf16x8 cf = *(const bf16x8*)(sK + (vt * 16 + r16) * 136 + ks * 32 + q * 8);
                    o[0] = MFMA(cf, fQ[0][ks], o[0]); o[1] = MFMA(cf, fQ[1][ks], o[1]);
                }
                const int v0 = vq * 64 + vt * 16 + 4 * q;
                const float4 gg = *(const float4*)(gmn + hd * 256 + v0);
#pragma unroll
                for (int jt = 0; jt < 2; ++jt) {
                    bf16_t* ptr = PROJ + (size_t)(t0 + 32 * w + 16 * jt + r16) * LDP + C_MO + hd * 256 + v0;
                    const uint2 mo = *(const uint2*)ptr;
                    const float m0 = __uint_as_float(mo.x << 16), m1 = __uint_as_float(mo.x & 0xffff0000u), m2 = __uint_as_float(mo.y << 16), m3 = __uint_as_float(mo.y & 0xffff0000u);
                    const float h0 = o[jt][0] * rden[jt], h1 = o[jt][1] * rden[jt], h2 = o[jt][2] * rden[jt], h3 = o[jt][3] * rden[jt];
                    ssq[jt] += h0 * h0 + h1 * h1 + h2 * h2 + h3 * h3;
                    uint2 ov; ov.x = pack2(sigmoidf_(m0) * h0 * gg.x, sigmoidf_(m1) * h1 * gg.y); ov.y = pack2(sigmoidf_(m2) * h2 * gg.z, sigmoidf_(m3) * h3 * gg.w);
                    *(uint2*)ptr = ov;
                }
            }
        }
#pragma unroll
        for (int jt = 0; jt < 2; ++jt) {
            float s2 = ssq[jt]; s2 += __shfl_xor(s2, 16); s2 += __shfl_xor(s2, 32);
            const float rstd = rsqrtf(s2 * (1.0f / 256.0f) + EPS);
#pragma unroll 2
            for (int vv = 0; vv < 16; ++vv) {
                bf16_t* ptr = PROJ + (size_t)(t0 + 32 * w + 16 * jt + r16) * LDP + C_MO + hd * 256 + vv * 16 + 4 * q;
                const uint2 yv = *(const uint2*)ptr;
                uint2 ov;
                ov.x = pack2(__uint_as_float(yv.x << 16) * rstd, __uint_as_float(yv.x & 0xffff0000u) * rstd);
                ov.y = pack2(__uint_as_float(yv.y << 16) * rstd, __uint_as_float(yv.y & 0xffff0000u) * rstd);
                *(uint2*)ptr = ov;
            }
        }
    }
}

__device__ __forceinline__ unsigned cvt_pk_bf16(float lo, float hi) { return pack2(lo, hi); }
typedef unsigned u32x4 __attribute__((ext_vector_type(4)));
template <int DK>
__device__ __forceinline__ void qk_tile(f32x4 (&s)[2][2], const bf16_t* sQw, const bf16_t* sKt, int coff, int r16, int q, float init) {
    const f32x4 initv = (f32x4){init, init, init, init};
#pragma unroll
    for (int ks = 0; ks < DK / 32; ++ks) {
        const bf16x8 q0 = *(const bf16x8*)(sQw + r16 * 136 + coff + ks * 32 + q * 8);
        const bf16x8 q1 = *(const bf16x8*)(sQw + (16 + r16) * 136 + coff + ks * 32 + q * 8);
#pragma unroll
        for (int st = 0; st < 2; ++st) {
            const bf16x8 kf = *(const bf16x8*)(sKt + (st * 16 + r16) * 136 + coff + ks * 32 + q * 8);
            s[st][0] = MFMA(kf, q0, ks == 0 ? initv : s[st][0]); s[st][1] = MFMA(kf, q1, ks == 0 ? initv : s[st][1]);
        }
    }
}
template <bool MASK>
__device__ __forceinline__ void make_p(bf16x8 (&pf)[2], const f32x4 (&s)[2][2], int key0  , int qpos0  ) {
#pragma unroll
    for (int jt = 0; jt < 2; ++jt) {
        float e[8];
#pragma unroll
        for (int st = 0; st < 2; ++st)
#pragma unroll
            for (int rr = 0; rr < 4; ++rr) {
                float v = __builtin_amdgcn_exp2f(s[st][jt][rr]);
                if (MASK) v = (key0 + st * 16 + rr <= qpos0 + 16 * jt) ? v : 0.f;
                e[st * 4 + rr] = v;
            }
        u32x4 pk; pk.x = cvt_pk_bf16(e[0], e[1]); pk.y = cvt_pk_bf16(e[2], e[3]); pk.z = cvt_pk_bf16(e[4], e[5]); pk.w = cvt_pk_bf16(e[6], e[7]);
        pf[jt] = *(const bf16x8*)&pk;
    }
}
__device__ __forceinline__ bf16x8 load_vfrag(const bf16_t* sVt, int vt, int kp, int r16, int q) {
    const bf16_t* vp = sVt + (vt * 16 + r16) * 72 + kp * 32 + 4 * q;
    const uint2 lo = *(const uint2*)vp, hi = *(const uint2*)(vp + 16);
    u32x4 cm; cm.x = lo.x; cm.y = lo.y; cm.z = hi.x; cm.w = hi.y;
    return *(const bf16x8*)&cm;
}
__device__ __forceinline__ bf16x8 ones_frag() { u32x4 o; o.x = o.y = o.z = o.w = 0x3f803f80u; return *(const bf16x8*)&o; }

template <bool MASK>
__device__ __forceinline__ void diff_tile(f32x4 (&O)[8][2], f32x4 (&L)[2], const bf16_t* sQw, const bf16_t* sK, const bf16_t* sVt,
                                          int r16, int q, float init, int key0, int qpos0) {
    const bf16x8 ones = ones_frag();
#pragma unroll
    for (int kp = 0; kp < 2; ++kp) {
        f32x4 s[2][2];
        const f32x4 initv = (f32x4){init, init, init, init};
#pragma unroll
        for (int ks = 0; ks < 2; ++ks) {
            const bf16x8 q0 = *(const bf16x8*)(sQw + r16 * 72 + ks * 32 + q * 8);
            const bf16x8 q1 = *(const bf16x8*)(sQw + (16 + r16) * 72 + ks * 32 + q * 8);
#pragma unroll
            for (int st = 0; st < 2; ++st) {
                const bf16x8 kf = *(const bf16x8*)(sK + (kp * 32 + st * 16 + r16) * 72 + ks * 32 + q * 8);
                s[st][0] = MFMA(kf, q0, ks == 0 ? initv : s[st][0]); s[st][1] = MFMA(kf, q1, ks == 0 ? initv : s[st][1]);
            }
        }
        bf16x8 pf[2];
        make_p<MASK>(pf, s, key0 + kp * 32, qpos0);
        __builtin_amdgcn_sched_barrier(0);
        __builtin_amdgcn_s_setprio(1);
        L[0] = MFMA(ones, pf[0], L[0]); L[1] = MFMA(ones, pf[1], L[1]);
#pragma unroll
        for (int vt = 0; vt < 8; ++vt) {
            const bf16x8 vf = load_vfrag(sVt, vt, kp, r16, q);
            O[vt][0] = MFMA(vf, pf[0], O[vt][0]); O[vt][1] = MFMA(vf, pf[1], O[vt][1]);
            if (vt == 3) __builtin_amdgcn_sched_barrier(0);
        }
        __builtin_amdgcn_s_setprio(0);
        __builtin_amdgcn_sched_barrier(0);
    }
}

__device__ __forceinline__ void diff_pass(f32x4 (&O)[8][2], f32x4 (&L)[2], const v4u (&qreg)[4], const bf16_t* PROJ, unsigned char* smem, int comp, int b, int hd, int qb, float init) {
    const int tid = opaque_tid(), lane = tid & 63, w = tid >> 6, r16 = lane & 15, q = lane >> 4;
    constexpr int SKB = 64 * 72, SVB = 128 * 72;
    bf16_t* sKb = (bf16_t*)smem;
    bf16_t* sVb = sKb + 2 * SKB;
    bf16_t* sQc = sVb + 2 * SVB;
#pragma unroll
    for (int vt = 0; vt < 8; ++vt) { O[vt][0] = O[vt][1] = (f32x4){0.f, 0.f, 0.f, 0.f}; }
    L[0] = L[1] = (f32x4){0.f, 0.f, 0.f, 0.f};
    const int nkt = 2 * qb + 2;
    const int qpos0 = qb * 128 + 32 * w + r16;
    const int krow = tid >> 3, kcc = tid & 7;
    const int vrow = tid >> 4, vcc = tid & 15;
    const bf16_t* gK = PROJ + (size_t)(b * SEQ + krow) * LDP + C_DK + hd * 128 + comp * 64 + kcc * 8;
    const bf16_t* gV = PROJ + (size_t)(b * SEQ + vrow) * LDP + C_DV + hd * 128 + vcc * 8;
    v4u rk[2], rv[4];
    rk[0] = *(const v4u*)gK; rk[1] = *(const v4u*)(gK + (size_t)32 * LDP);
#pragma unroll
    for (int i = 0; i < 4; ++i) rv[i] = *(const v4u*)(gV + (size_t)(16 * i) * LDP);
    __syncthreads();
#pragma unroll
    for (int i = 0; i < 4; ++i) *(v4u*)(sQc + (krow + 32 * i) * 72 + kcc * 8) = qreg[i];
    *(v4u*)(sKb + krow * 72 + kcc * 8) = rk[0]; *(v4u*)(sKb + (krow + 32) * 72 + kcc * 8) = rk[1];
#pragma unroll
    for (int i = 0; i < 4; ++i) *(v4u*)(sVb + (2 * (vrow + 16 * i) + (vcc >> 3)) * 72 + (vcc & 7) * 8) = rv[i];
    __syncthreads();
#pragma unroll 1
    for (int kt = 0; kt < nkt; ++kt) {
        const int cur = kt & 1;
        {
            const int kn = (kt + 1 < nkt) ? kt + 1 : kt;
            const size_t off = (size_t)kn * 64 * LDP;
            rk[0] = *(const v4u*)(gK + off); rk[1] = *(const v4u*)(gK + off + (size_t)32 * LDP);
#pragma unroll
            for (int i = 0; i < 4; ++i) rv[i] = *(const v4u*)(gV + off + (size_t)(16 * i) * LDP);
        }
        __builtin_amdgcn_sched_barrier(0);
        if (kt < 2 * qb) diff_tile<false>(O, L, sQc + (32 * w) * 72, sKb + cur * SKB, sVb + cur * SVB, r16, q, init, 0, 0);
        else             diff_tile<true>(O, L, sQc + (32 * w) * 72, sKb + cur * SKB, sVb + cur * SVB, r16, q, init, kt * 64 + 4 * q, qpos0);
        {
            bf16_t* dk = sKb + (cur ^ 1) * SKB; bf16_t* dv = sVb + (cur ^ 1) * SVB;
            *(v4u*)(dk + krow * 72 + kcc * 8) = rk[0]; *(v4u*)(dk + (krow + 32) * 72 + kcc * 8) = rk[1];
#pragma unroll
            for (int i = 0; i < 4; ++i) *(v4u*)(dv + (2 * (vrow + 16 * i) + (vcc >> 3)) * 72 + (vcc & 7) * 8) = rv[i];
        }
        __syncthreads();
    }
}

__device__ void phase3(const Params& p, unsigned char* smem, int* s_task) {
    unsigned char* ws = p.ws;
    const int tid = opaque_tid(), lane = tid & 63, w = tid >> 6, r16 = lane & 15, q = lane >> 4;
    bf16_t* PROJ = (bf16_t*)(ws + OFF_PROJ);
    unsigned* ctr = (unsigned*)(ws + OFF_CTR);
    const float l1 = wave_sum(p.in[11][lane] * p.in[12][lane]), l2 = wave_sum(p.in[13][lane] * p.in[14][lane]);
    const float gq = wave_max(fabsf(p.in[9][lane])), gk = wave_max(fabsf(p.in[10][lane]));
    const float lam = __expf(l1) - __expf(l2) + 0.2f;
    const float init = -8.0f * gq * gk * 1.4426950408889634f;
    const float* sg = p.in[15];
    while (true) {
        __syncthreads();
        const int xcd = blockIdx.x & 7;
        if (tid == 0) *s_task = (int)atomicAdd(ctr + 8 + xcd, 1u);
        __syncthreads();
        const int task = *s_task;
        if (task >= 256) break;
        const int lane = opaque_tid() & 63, w = opaque_tid() >> 6, r16 = lane & 15, q = lane >> 4;
        const int qb = 63 - (task & 63), bh = xcd + 8 * (task >> 6), hd = bh & 7, b = bh >> 3, tq0 = b * SEQ + qb * 128;
        f32x4 O[8][2], L[2];
        v4u qreg[4];
        const int tid2 = opaque_tid();
        const bf16_t* gQ = PROJ + (size_t)(tq0 + (tid2 >> 3)) * LDP + C_DQ + hd * 128 + (tid2 & 7) * 8;
        bf16_t* yrow0 = PROJ + (size_t)(tq0 + 32 * w + r16) * LDP + C_DQ + hd * 128;
#pragma unroll
        for (int i = 0; i < 4; ++i) qreg[i] = *(const v4u*)(gQ + (size_t)(32 * i) * LDP);
        diff_pass(O, L, qreg, PROJ, smem, 0, b, hd, qb, init);
#pragma unroll
        for (int i = 0; i < 4; ++i) qreg[i] = *(const v4u*)(gQ + (size_t)(32 * i) * LDP + 64);
        asm volatile("s_waitcnt vmcnt(0)" ::: "memory");
        __syncthreads();
#pragma unroll
        for (int jt = 0; jt < 2; ++jt) {
            const float r1 = 1.0f / L[jt][0];
#pragma unroll
            for (int vt = 0; vt < 8; ++vt) {
                uint2 ov; ov.x = cvt_pk_bf16(O[vt][jt][0] * r1, O[vt][jt][1] * r1); ov.y = cvt_pk_bf16(O[vt][jt][2] * r1, O[vt][jt][3] * r1);
                *(uint2*)(yrow0 + (size_t)(16 * jt) * LDP + vt * 16 + 4 * q) = ov;
            }
        }
        diff_pass(O, L, qreg, PROJ, smem, 1, b, hd, qb, init);
#pragma unroll
        for (int jt = 0; jt < 2; ++jt) {
            const float r2 = lam / L[jt][0];
            float ss = 0.f;
#pragma unroll
            for (int vt = 0; vt < 8; ++vt) {
                const uint2 sv = *(const uint2*)(yrow0 + (size_t)(16 * jt) * LDP + vt * 16 + 4 * q);
                const float a0 = __uint_as_float(sv.x << 16), a1 = __uint_as_float(sv.x & 0xffff0000u);
                const float a2 = __uint_as_float(sv.y << 16), a3 = __uint_as_float(sv.y & 0xffff0000u);
                const float o0 = a0 - O[vt][jt][0] * r2, o1 = a1 - O[vt][jt][1] * r2, o2 = a2 - O[vt][jt][2] * r2, o3 = a3 - O[vt][jt][3] * r2;
                O[vt][jt][0] = o0; O[vt][jt][1] = o1; O[vt][jt][2] = o2; O[vt][jt][3] = o3;
                ss += o0 * o0 + o1 * o1 + o2 * o2 + o3 * o3;
            }
            ss += __shfl_xor(ss, 16); ss += __shfl_xor(ss, 32);
            const float rstd = rsqrtf(ss * (1.0f / 128.0f) + EPS) * 0.8f;
#pragma unroll
            for (int vt = 0; vt < 8; ++vt) {
                const int v0 = vt * 16 + 4 * q;
                const float4 gg = *(const float4*)(sg + v0);
                uint2 ov; ov.x = cvt_pk_bf16(O[vt][jt][0] * rstd * gg.x, O[vt][jt][1] * rstd * gg.y); ov.y = cvt_pk_bf16(O[vt][jt][2] * rstd * gg.z, O[vt][jt][3] * rstd * gg.w);
                *(uint2*)(PROJ + (size_t)(tq0 + 32 * w + 16 * jt + r16) * LDP + C_DQ + hd * 128 + v0) = ov;
            }
        }
    }
}

__device__ void phase4(const Params& p, unsigned char* smem) {
    unsigned char* ws = p.ws;
    const int tid = opaque_tid(), lane = tid & 63, w = tid >> 6, r16 = lane & 15, q = lane >> 4;
    bf16_t* PROJ = (bf16_t*)(ws + OFF_PROJ);
    const bf16_t* MKN = (const bf16_t*)(ws + OFF_MKN); const bf16_t* VTC = (const bf16_t*)(ws + OFF_VTC);
    bf16_t* sQ = (bf16_t*)smem; bf16_t* sK = sQ + 128 * 136; bf16_t* sVt = sK + 64 * 136;
    const float gq = wave_max(fmaxf(fabsf(p.in[16][lane]), fabsf(p.in[16][lane + 64])));
    const float gk = wave_max(fmaxf(fabsf(p.in[17][lane]), fabsf(p.in[17][lane + 64])));
    const float init = -11.313708498984761f * gq * gk * 1.4426950408889634f;
    const bf16x8 ones = ones_frag();
    for (int task = blockIdx.x; task < 2048; task += gridDim.x) {
        const int tid = opaque_tid(), lane = tid & 63, w = tid >> 6, r16 = lane & 15, q = lane >> 4;
        const int vhalf = task & 1, qt = (task >> 1) & 63, bh = task >> 7, hc = bh & 3, b = bh >> 2, tq0 = b * SEQ + qt * 128;
        __syncthreads();
#pragma unroll
        for (int i = 0; i < 8; ++i) {
            const int id = tid + i * 256, row = id >> 4, cc = id & 15;
            *(uint4*)(sQ + row * 136 + cc * 8) = *(const uint4*)(PROJ + (size_t)(tq0 + row) * LDP + C_CQ + hc * 128 + cc * 8);
        }
        f32x4 O[8][2], L[2];
#pragma unroll
        for (int vt = 0; vt < 8; ++vt) { O[vt][0] = O[vt][1] = (f32x4){0.f, 0.f, 0.f, 0.f}; }
        L[0] = L[1] = (f32x4){0.f, 0.f, 0.f, 0.f};
        const bf16_t* gKm = MKN + (size_t)(b * 256 + (tid >> 4)) * 512 + hc * 128 + (tid & 15) * 8;
        const bf16_t* gVm = VTC + ((size_t)((b * 4 + hc) * 256 + vhalf * 128 + (tid >> 3))) * 256 + (tid & 7) * 8;
        v4u rk[4], rv[4];
#pragma unroll
        for (int i = 0; i < 4; ++i) { rk[i] = *(const v4u*)(gKm + (size_t)(16 * i) * 512); rv[i] = *(const v4u*)(gVm + (size_t)(32 * i) * 256); }
#pragma unroll 1
        for (int kt = 0; kt < 4; ++kt) {
            __syncthreads();
#pragma unroll
            for (int i = 0; i < 4; ++i) {
                *(v4u*)(sK + ((tid >> 4) + 16 * i) * 136 + (tid & 15) * 8) = rk[i];
                *(v4u*)(sVt + ((tid >> 3) + 32 * i) * 72 + (tid & 7) * 8) = rv[i];
            }
            __syncthreads();
            {
                const int kn = kt < 3 ? kt + 1 : 3;
#pragma unroll
                for (int i = 0; i < 4; ++i) { rk[i] = *(const v4u*)(gKm + (size_t)(kn * 64 + 16 * i) * 512); rv[i] = *(const v4u*)(gVm + (size_t)(32 * i) * 256 + kn * 64); }
            }
            __builtin_amdgcn_sched_barrier(0);
#pragma unroll
            for (int kp = 0; kp < 2; ++kp) {
                f32x4 s[2][2];
                qk_tile<128>(s, sQ + (32 * w) * 136, sK + (kp * 32) * 136, 0, r16, q, init);
                bf16x8 pf[2];
                make_p<false>(pf, s, 0, 0);
                L[0] = MFMA(ones, pf[0], L[0]); L[1] = MFMA(ones, pf[1], L[1]);
#pragma unroll
                for (int vt = 0; vt < 8; ++vt) {
                    const bf16x8 vf = load_vfrag(sVt, vt, kp, r16, q);
                    O[vt][0] = MFMA(vf, pf[0], O[vt][0]); O[vt][1] = MFMA(vf, pf[1], O[vt][1]);
                }
            }
        }
#pragma unroll
        for (int jt = 0; jt < 2; ++jt) {
            const float r1 = 1.0f / L[jt][0];
#pragma unroll
            for (int vt = 0; vt < 8; ++vt) {
                const int v0 = vhalf * 128 + vt * 16 + 4 * q;
                uint2 ov; ov.x = cvt_pk_bf16(O[vt][jt][0] * r1, O[vt][jt][1] * r1); ov.y = cvt_pk_bf16(O[vt][jt][2] * r1, O[vt][jt][3] * r1);
                *(uint2*)(PROJ + (size_t)(tq0 + 32 * w + 16 * jt + r16) * LDP + C_DK + hc * 256 + v0) = ov;
            }
        }
    }
}

__device__ void phase5(const Params& p, unsigned char* smem) {
    unsigned char* ws = p.ws;
    const int tid = opaque_tid(), lane = tid & 63, w = tid >> 6, r16 = lane & 15, q = lane >> 4, wa = w & 1, wb = w >> 1;
    bf16_t* PROJ = (bf16_t*)(ws + OFF_PROJ);
    const bf16_t* H = (const bf16_t*)((unsigned char*)p.out + OUT_H);
    const float* bg = p.in[21];
    for (int tile = blockIdx.x; tile < 256 * 8; tile += gridDim.x) {
        int mt, nt; map_tile(tile, 8, mt, nt);
        const int m0 = mt * 128, n0 = nt * 128;
#pragma unroll 1
        for (int br = 0; br < 3; ++br) {
            const int ycol = br == 0 ? C_MO : (br == 1 ? C_DQ : C_DK);
            const size_t woff = br == 0 ? OFF_WPM : (br == 1 ? OFF_WPD : OFF_WPC);
            unsigned gpk[4][4][2];
            f32x4 acc[4][4];
            zero_acc<4>(acc);
            gemm_acc<128, false>(acc, H + (size_t)m0 * 1024, 1024, (const bf16_t*)(ws + OFF_WG) + (size_t)(br * 1024 + n0) * 1024, 1024, 1024, smem);
            const int t1 = opaque_tid(), q1 = (t1 & 63) >> 4, wa1 = (t1 >> 6) & 1;
#pragma unroll
            for (int i = 0; i < 4; ++i) {
                const int n = n0 + wa1 * 64 + i * 16 + nq_of(q1);
                const float4 bb = *(const float4*)(bg + br * 1024 + n);
#pragma unroll
                for (int j = 0; j < 4; ++j) {
                    gpk[i][j][0] = pack2(sigmoidf_(acc[i][j][0] + bb.x), sigmoidf_(acc[i][j][1] + bb.y));
                    gpk[i][j][1] = pack2(sigmoidf_(acc[i][j][2] + bb.z), sigmoidf_(acc[i][j][3] + bb.w));
                }
            }
            zero_acc<4>(acc);
            gemm_acc<128, false>(acc, PROJ + (size_t)m0 * LDP + ycol, LDP, (const bf16_t*)(ws + woff) + (size_t)n0 * 1024, 1024, 1024, smem);
            const int t2 = opaque_tid(), l2 = t2 & 63, w2 = t2 >> 6, r2 = l2 & 15, q2 = l2 >> 4, wa2 = w2 & 1, wb2 = w2 >> 1;
#pragma unroll
            for (int i = 0; i < 4; i += 2)
#pragma unroll
                for (int j = 0; j < 4; ++j) {
                    const int n = n0 + wa2 * 64 + (i + (q2 >> 1)) * 16 + 8 * (q2 & 1), m = m0 + wb2 * 64 + j * 16 + r2;
                    v4u* mp = (v4u*)(PROJ + (size_t)m * LDP + C_DV + n);
                    float mv[2][4];
#pragma unroll
                    for (int e = 0; e < 2; ++e) {
                        mv[e][0] = __uint_as_float(gpk[i + e][j][0] << 16) * acc[i + e][j][0]; mv[e][1] = __uint_as_float(gpk[i + e][j][0] & 0xffff0000u) * acc[i + e][j][1];
                        mv[e][2] = __uint_as_float(gpk[i + e][j][1] << 16) * acc[i + e][j][2]; mv[e][3] = __uint_as_float(gpk[i + e][j][1] & 0xffff0000u) * acc[i + e][j][3];
                    }
                    if (br > 0) {
                        const v4u pv = *mp;
                        unsigned ax = pv.x, ay = pv.y, bx = pv.z, by = pv.w;
                        { auto r_ = __builtin_amdgcn_permlane32_swap(ax, bx, false, false); ax = r_[0]; bx = r_[1]; }
                        { auto r_ = __builtin_amdgcn_permlane32_swap(ay, by, false, false); ay = r_[0]; by = r_[1]; }
                        mv[0][0] += __uint_as_float(ax << 16); mv[0][1] += __uint_as_float(ax & 0xffff0000u); mv[0][2] += __uint_as_float(ay << 16); mv[0][3] += __uint_as_float(ay & 0xffff0000u);
                        mv[1][0] += __uint_as_float(bx << 16); mv[1][1] += __uint_as_float(bx & 0xffff0000u); mv[1][2] += __uint_as_float(by << 16); mv[1][3] += __uint_as_float(by & 0xffff0000u);
                    }
                    unsigned ax = pack2(mv[0][0], mv[0][1]), ay = pack2(mv[0][2], mv[0][3]), bx = pack2(mv[1][0], mv[1][1]), by = pack2(mv[1][2], mv[1][3]);
                    { auto r_ = __builtin_amdgcn_permlane32_swap(ax, bx, false, false); ax = r_[0]; bx = r_[1]; }
                    { auto r_ = __builtin_amdgcn_permlane32_swap(ay, by, false, false); ay = r_[0]; by = r_[1]; }
                    v4u o; o.x = ax; o.y = ay; o.z = bx; o.w = by;
                    *mp = o;
                }
        }
    }
}

__device__ void phase6(const Params& p, unsigned char* smem) {
    unsigned char* ws = p.ws;
    bf16_t* PROJ = (bf16_t*)(ws + OFF_PROJ);
    bf16_t* X1B = (bf16_t*)((unsigned char*)p.out + OUT_H);
    float* SSQ = (float*)(ws + OFF_SSQ);
    const float* x = p.in[0];
    for (int tile = blockIdx.x; tile < 256 * 8; tile += gridDim.x) {
        int mt, nt; map_tile(tile, 8, mt, nt);
        const int m0 = mt * 128, n0 = nt * 128;
        f32x4 acc[4][4]; zero_acc<4>(acc);
        gemm_acc<128, false>(acc, PROJ + (size_t)m0 * LDP + C_DV, LDP, (const bf16_t*)(ws + OFF_WOUT) + (size_t)n0 * 1024, 1024, 1024, smem);
        const int tid = opaque_tid(), lane = tid & 63, w = tid >> 6, r16 = lane & 15, q = lane >> 4, wa = w & 1, wb = w >> 1;
#pragma unroll
        for (int j = 0; j < 4; ++j) {
            const int m = m0 + wb * 64 + j * 16 + r16;
#pragma unroll
            for (int i = 0; i < 4; ++i) {
                const int n = n0 + wa * 64 + i * 16 + nq_of(q);
                const float4 xv = *(const float4*)(x + (size_t)m * 1024 + n);
                float4 o; o.x = xv.x + acc[i][j][0]; o.y = xv.y + acc[i][j][1]; o.z = xv.z + acc[i][j][2]; o.w = xv.w + acc[i][j][3];
                *(float4*)((float*)(PROJ + (size_t)m * LDP) + n) = o;
            }
        }
    }
}


__device__ void phase6b(const Params& p) {
    unsigned char* ws = p.ws;
    const int tid = opaque_tid(), lane = tid & 63, w = tid >> 6;
    const bf16_t* PROJ = (const bf16_t*)(ws + OFF_PROJ);
    bf16_t* X1B = (bf16_t*)((unsigned char*)p.out + OUT_H);
    float* SSQ = (float*)(ws + OFF_SSQ);
    const int rstride = gridDim.x * 4;
    float4 vn[4];
    {
        const float* src = (const float*)(PROJ + (size_t)(blockIdx.x * 4 + w) * LDP);
#pragma unroll
        for (int i = 0; i < 4; ++i) vn[i] = *(const float4*)(src + lane * 4 + 256 * i);
    }
    for (int row = blockIdx.x * 4 + w; row < T_TOK; row += rstride) {
        float4 v[4]; float ss = 0.f;
#pragma unroll
        for (int i = 0; i < 4; ++i) { v[i] = vn[i]; ss += v[i].x * v[i].x + v[i].y * v[i].y + v[i].z * v[i].z + v[i].w * v[i].w; }
        {
            const int rn = (row + rstride < T_TOK) ? row + rstride : row;
            const float* srcn = (const float*)(PROJ + (size_t)rn * LDP);
#pragma unroll
            for (int i = 0; i < 4; ++i) vn[i] = *(const float4*)(srcn + lane * 4 + 256 * i);
        }
        ss = wave_sum(ss);
        if (lane == 0) SSQ[row] = ss;
#pragma unroll
        for (int i = 0; i < 4; ++i) {
            uint2 o; o.x = pack2(v[i].x, v[i].y); o.y = pack2(v[i].z, v[i].w);
            *(uint2*)(X1B + (size_t)row * 1024 + lane * 4 + 256 * i) = o;
        }
    }
}


__device__ void phase7(const Params& p, unsigned char* smem) {
    unsigned char* ws = p.ws;
    bf16_t* PROJ = (bf16_t*)(ws + OFF_PROJ);
    const bf16_t* H2 = (const bf16_t*)((unsigned char*)p.out + OUT_H);
    const float* SSQ = (const float*)(ws + OFF_SSQ);
    for (int tile = blockIdx.x; tile < 256 * 16; tile += gridDim.x) {
        int mt, nt; map_tile(tile, 16, mt, nt);
        const int m0 = mt * 128, n0 = nt * 256;
        f32x4 acc[8][4];
#pragma unroll
        for (int i = 0; i < 8; ++i)
#pragma unroll
            for (int j = 0; j < 4; ++j) acc[i][j] = (f32x4){0.f, 0.f, 0.f, 0.f};
        gemm_wide(acc, H2 + (size_t)m0 * 1024, 1024, (const bf16_t*)(ws + OFF_WUP) + (size_t)n0 * 1024, 1024, 1024, smem);
        const int tid = opaque_tid(), lane = tid & 63, w = tid >> 6, r16 = lane & 15, q = lane >> 4, wa = w & 1, wb = w >> 1;
#pragma unroll
        for (int j = 0; j < 4; ++j) {
            const int m = m0 + wb * 64 + j * 16 + r16;
            const float r2 = 1.0f / (SSQ[m] * (1.0f / 1024.0f) + EPS);
#pragma unroll
            for (int i = 0; i < 8; i += 2) {
                const int n = n0 + wa * 128 + (i + (q >> 1)) * 16 + 8 * (q & 1);
                unsigned pk[2][2];
#pragma unroll
                for (int e = 0; e < 2; ++e) {
                    const float a0 = fmaxf(acc[i + e][j][0], 0.f), a1 = fmaxf(acc[i + e][j][1], 0.f), a2 = fmaxf(acc[i + e][j][2], 0.f), a3 = fmaxf(acc[i + e][j][3], 0.f);
                    pk[e][0] = pack2(a0 * a0 * r2, a1 * a1 * r2); pk[e][1] = pack2(a2 * a2 * r2, a3 * a3 * r2);
                }
                { auto r_ = __builtin_amdgcn_permlane32_swap(pk[0][0], pk[1][0], false, false); pk[0][0] = r_[0]; pk[1][0] = r_[1]; }
                { auto r_ = __builtin_amdgcn_permlane32_swap(pk[0][1], pk[1][1], false, false); pk[0][1] = r_[0]; pk[1][1] = r_[1]; }
                v4u o; o.x = pk[0][0]; o.y = pk[0][1]; o.z = pk[1][0]; o.w = pk[1][1];
                *(v4u*)(PROJ + (size_t)m * LDP + 2048 + n) = o;
            }
        }
    }
}

__device__ void phase8(const Params& p, unsigned char* smem) {
    unsigned char* ws = p.ws;
    const bf16_t* PROJ = (const bf16_t*)(ws + OFF_PROJ);
    for (int tile = blockIdx.x; tile < 256 * 4; tile += gridDim.x) {
        int mt, nt; map_tile(tile, 4, mt, nt);
        const int m0 = mt * 128, n0 = nt * 256;
        f32x4 acc[8][4];
#pragma unroll
        for (int i = 0; i < 8; ++i)
#pragma unroll
            for (int j = 0; j < 4; ++j) acc[i][j] = (f32x4){0.f, 0.f, 0.f, 0.f};
        gemm_wide(acc, PROJ + (size_t)m0 * LDP + 2048, LDP, (const bf16_t*)(ws + OFF_WDN) + (size_t)n0 * 4096, 4096, 4096, smem);
        const int tid = opaque_tid(), lane = tid & 63, w = tid >> 6, r16 = lane & 15, q = lane >> 4, wa = w & 1, wb = w >> 1;
#pragma unroll
        for (int j = 0; j < 4; ++j) {
            const int m = m0 + wb * 64 + j * 16 + r16;
#pragma unroll
            for (int i = 0; i < 8; ++i) {
                const int n = n0 + wa * 128 + i * 16 + nq_of(q);
                const float4 xv = *(const float4*)((const float*)(PROJ + (size_t)m * LDP) + n);
                float4 o; o.x = xv.x + acc[i][j][0]; o.y = xv.y + acc[i][j][1]; o.z = xv.z + acc[i][j][2]; o.w = xv.w + acc[i][j][3];
                *(float4*)(p.out + (size_t)m * 1024 + n) = o;
            }
        }
    }
}


constexpr int N_PHASES = 13;
__global__ void __launch_bounds__(256, 2) fwd_megakernel(Params p) {
    __shared__ __attribute__((aligned(16))) unsigned char smem[73728];
    __shared__ int s_task;
    const int ph_lo = (int)(p.ph_lo_hi & 0xffffffffll), ph_hi = (int)(p.ph_lo_hi >> 32);
    __shared__ uint4 xb_words;
    unsigned* xbar = (unsigned*)(p.ws + OFF_XBAR);
    if (threadIdx.x == 0) { xb_words = make_uint4(0u, 0u, 0u, 0u); (void)xb_add(&xbar[XB_XCNT(xb_xcc_id())], 1u); }
    __syncthreads();
    if (p.ph_lo_hi == -1) cg::this_grid().sync();
#ifndef PROBE_DOUBLE
#define PROBE_DOUBLE 0
#endif
#define RUN_PHASE(N, CALL) if (ph_lo <= (N) && (N) < ph_hi) { CALL; if ((N) + 1 < ph_hi) xcd_barrier(xbar, (volatile LAS unsigned*)&xb_words); }
    RUN_PHASE(0, phase0(p, smem))
    RUN_PHASE(1, phase1(p, smem))
    RUN_PHASE(2, phase2a(p, smem))
    RUN_PHASE(3, phase2b(p, smem))
    RUN_PHASE(4, phase2c(p))
    RUN_PHASE(5, phase2d(p, smem))
    RUN_PHASE(6, phase3(p, smem, &s_task))
    RUN_PHASE(7, phase4(p, smem))
    RUN_PHASE(8, phase5(p, smem))
    RUN_PHASE(9, phase6(p, smem))
    RUN_PHASE(10, phase6b(p))
    RUN_PHASE(11, phase7(p, smem))
    RUN_PHASE(12, phase8(p, smem))
}

extern "C" void kernel_launch(void* const* d_in, const int* in_sizes, int n_in, void* d_out, int out_size, void* d_ws, size_t ws_size, hipStream_t stream) {
    static int grid_blocks = 0;
    if (!grid_blocks) {
        if (n_in != 29 || out_size != T_TOK * DM || ws_size < WS_END) {
            fprintf(stderr, "kernel_launch: unexpected shapes n_in %d out %d ws %zu (need %zu)\n", n_in, out_size, ws_size, (size_t)WS_END);
            grid_blocks = -1; return;
        }
        int dev = 0, cus = 0, per_cu = 0;
        hipGetDevice(&dev);
        hipDeviceGetAttribute(&cus, hipDeviceAttributeMultiprocessorCount, dev);
        hipOccupancyMaxActiveBlocksPerMultiprocessor(&per_cu, fwd_megakernel, 256, 0);
        if (per_cu < 1) per_cu = 1;
        if (per_cu > 2) per_cu = 2;
        grid_blocks = cus * per_cu;
        grid_blocks &= ~7;
        fprintf(stderr, "kernel_launch: cus %d per_cu %d grid %d ws %zu need %zu\n", cus, per_cu, grid_blocks, ws_size, (size_t)WS_END);
    }
    if (grid_blocks < 0) return;
    hipMemsetAsync((unsigned char*)d_ws + OFF_CTR, 0, 256 + 16384, stream);
    Params p{};
    for (int i = 0; i < 29; ++i) p.in[i] = (const float*)d_in[i];
    p.out = (float*)d_out; p.ws = (unsigned char*)d_ws;
#if MULTI_LAUNCH
    for (int ph = 0; ph < N_PHASES; ++ph) {
        p.ph_lo_hi = (long long)ph | ((long long)(ph + 1) << 32);
        hipLaunchKernelGGL(fwd_megakernel, dim3(grid_blocks), dim3(256), 0, stream, p);
    }
#else
    p.ph_lo_hi = 0ll | ((long long)N_PHASES << 32);
    void* args[] = {&p};
    hipError_t e = hipLaunchCooperativeKernel((const void*)fwd_megakernel, dim3(grid_blocks), dim3(256), args, 0, stream);
    if (e != hipSuccess) fprintf(stderr, "cooperative launch failed: %s (grid %d)\n", hipGetErrorString(e), grid_blocks);
#endif
}
```
